# Optimizing an MI355X kernel written in HIP

```python
import jax, jax.numpy as jnp
from jax import lax
import numpy as np

D_MODEL = 1024
BATCH = 4
SEQ = 8192
DEPTH = 4

GRID_W = 64
CTX_LEN = 256
MOD_CHUNKS = 9
D_FF = 2816
EPS = 1e-6

LRU_WIDTH = 384
LRU_BLOCKS = 6
LRU_BLOCK_W = LRU_WIDTH // LRU_BLOCKS
LRU_C = 8.0
CONV_W = 4
CONV_LEFT = 2

MLA_HEADS = 6
MLA_Q_RANK = 256
MLA_KV_RANK = 128
MLA_NOPE = 64
MLA_ROPE = 32
MLA_QK_DIM = MLA_NOPE + MLA_ROPE
MLA_V = 64
ROPE_BASE = 10000.0
ATTN_BLOCK = 128

NA_HEADS = 4
NA_HEAD_DIM = 64
NA_WIDTH = NA_HEADS * NA_HEAD_DIM
NA_WIN_ROWS = 8
NA_WIN_COLS = 16
NA_QCOL_BLOCK = 16
NA_KCOL_BLOCK = 32

MIX_WIDTH = LRU_WIDTH + MLA_HEADS * MLA_V + NA_WIDTH
IN_SPLITS = (LRU_WIDTH, LRU_WIDTH, MLA_Q_RANK, MLA_KV_RANK, MLA_ROPE, NA_WIDTH, NA_WIDTH, NA_WIDTH)
IN_WIDTH = 1952

kernel_name = 'hybrid_lru_mla_natten_macaron_dit'


def rms_norm(x, g):
    xf = x.astype(jnp.float32)
    y = xf * lax.rsqrt(jnp.mean(xf * xf, axis=-1, keepdims=True) + EPS)
    return (y * g.astype(jnp.float32)).astype(x.dtype)


def modulate(x, shift, scale):
    return x * (1 + scale[:, None, :]) + shift[:, None, :]


def swiglu(x, w_in, w_out):
    gate, up = jnp.split(x @ w_in, 2, axis=-1)
    return (jax.nn.silu(gate) * up) @ w_out


def split_columns(y):
    parts, start = [], 0
    for width in IN_SPLITS:
        parts.append(y[..., start:start + width])
        start += width
    return parts


def attention(q, k, v):
    s = jnp.einsum('bhqd,bhkd->bhqk', q, k).astype(jnp.float32) * (q.shape[-1] ** -0.5)
    p = jax.nn.softmax(s, axis=-1).astype(v.dtype)
    return jnp.einsum('bhqk,bhkd->bhqd', p, v)


def blocked_attention(q, k, v):
    B, H, T, _ = q.shape
    nb = T // ATTN_BLOCK
    qb = jnp.moveaxis(q.reshape(B, H, nb, ATTN_BLOCK, q.shape[-1]), 2, 0)
    ob = lax.map(lambda qi: attention(qi, k, v), qb)
    return jnp.moveaxis(ob, 0, 2).reshape(B, H, T, v.shape[-1])


def axial_rope(T, dtype):
    t = jnp.arange(T)
    pos = jnp.stack([t // GRID_W, t % GRID_W], axis=-1).astype(jnp.float32)
    half = MLA_ROPE // 2
    inv = ROPE_BASE ** (-jnp.arange(0, half, 2, dtype=jnp.float32) / half)
    ang = pos[:, None, :, None] * inv
    return jnp.cos(ang).astype(dtype), jnp.sin(ang).astype(dtype)


def apply_rope(x, cos, sin):
    xs = x.reshape(*x.shape[:-1], 2, 2, MLA_ROPE // 4)
    x1, x2 = xs[..., 0, :], xs[..., 1, :]
    out = jnp.stack([x1 * cos - x2 * sin, x2 * cos + x1 * sin], axis=-2)
    return out.reshape(x.shape)


def depthwise_conv(x, w, b):
    T = x.shape[1]
    xp = jnp.pad(x, ((0, 0), (CONV_LEFT, CONV_W - 1 - CONV_LEFT), (0, 0)))
    y = b
    for j in range(CONV_W):
        y = y + xp[:, j:j + T] * w[j]
    return y


def rglru(x, w_a, b_a, w_x, b_x, lam, h0):
    B, T, W = x.shape
    xb = x.reshape(B, T, LRU_BLOCKS, LRU_BLOCK_W)
    r = jax.nn.sigmoid(jnp.einsum('btnc,ncd->btnd', xb, w_a).reshape(B, T, W) + b_a).astype(jnp.float32)
    i = jax.nn.sigmoid(jnp.einsum('btnc,ncd->btnd', xb, w_x).reshape(B, T, W) + b_x)
    log_a = -LRU_C * r * jax.nn.softplus(-lam.astype(jnp.float32))
    a = jnp.exp(log_a)
    u = jnp.sqrt(-jnp.expm1(2.0 * log_a)) * (i * x).astype(jnp.float32)
    u = u.at[:, 0].add(a[:, 0] * h0.astype(jnp.float32))

    def combine(left, right):
        a_l, b_l = left
        a_r, b_r = right
        return a_l * a_r, a_r * b_l + b_r

    _, h = lax.associative_scan(combine, (a, u), axis=1)
    return h.astype(x.dtype)


def bidir_rglru(u_c, u_l, w_a, b_a, w_x, b_x, lam, need_ctx):
    zeros = jnp.zeros((u_c.shape[0], u_c.shape[2]), u_c.dtype)
    hc_f = rglru(u_c, w_a[0], b_a[0], w_x[0], b_x[0], lam[0], zeros)
    hl_f = rglru(u_l, w_a[0], b_a[0], w_x[0], b_x[0], lam[0], hc_f[:, -1])
    hc_b = jnp.flip(rglru(jnp.flip(u_c, 1), w_a[1], b_a[1], w_x[1], b_x[1], lam[1], zeros), 1)
    hl_b = jnp.flip(rglru(jnp.flip(u_l, 1), w_a[1], b_a[1], w_x[1], b_x[1], lam[1], hc_b[:, 0]), 1)
    yc = hc_f + hc_b if need_ctx else None
    return yc, hl_f + hl_b


def mla_queries(cq, q_norm, w_uq, q_gain, cos=None, sin=None):
    B, T, _ = cq.shape
    q = rms_norm((rms_norm(cq, q_norm) @ w_uq).reshape(B, T, MLA_HEADS, MLA_QK_DIM), q_gain)
    if cos is not None:
        q = jnp.concatenate([q[..., :MLA_NOPE], apply_rope(q[..., MLA_NOPE:], cos, sin)], axis=-1)
    return q.transpose(0, 2, 1, 3)


def mla_keys_values(ckv, kr, kv_norm, w_ukv, k_gain, cos=None, sin=None):
    B, T, _ = ckv.shape
    kv = (rms_norm(ckv, kv_norm) @ w_ukv).reshape(B, T, MLA_HEADS, MLA_NOPE + MLA_V)
    k_nope, v = kv[..., :MLA_NOPE], kv[..., MLA_NOPE:]
    k_rope = jnp.broadcast_to(kr[:, :, None, :], (B, T, MLA_HEADS, MLA_ROPE))
    k = rms_norm(jnp.concatenate([k_nope, k_rope], axis=-1), k_gain)
    if cos is not None:
        k = jnp.concatenate([k[..., :MLA_NOPE], apply_rope(k[..., MLA_NOPE:], cos, sin)], axis=-1)
    return k.transpose(0, 2, 1, 3), v.transpose(0, 2, 1, 3)


def neighborhood_attention(q, k, v, k_ctx, v_ctx, rpb):
    B, T, H, dh = q.shape
    rows = T // GRID_W
    wr = min(NA_WIN_ROWS, rows)
    n_cb = GRID_W // NA_QCOL_BLOCK
    n_loc = wr * NA_KCOL_BLOCK
    qg = q.reshape(B, rows, GRID_W, H, dh)
    kg = k.reshape(B, rows, GRID_W, H, dh)
    vg = v.reshape(B, rows, GRID_W, H, dh)
    q_rows = jnp.arange(rows)
    row_start = jnp.clip(q_rows - wr // 2, 0, rows - wr)
    q_cols = jnp.arange(GRID_W).reshape(n_cb, NA_QCOL_BLOCK)
    win_start = jnp.clip(q_cols - NA_WIN_COLS // 2, 0, GRID_W - NA_WIN_COLS)
    kblk_start = jnp.clip(jnp.arange(n_cb) * NA_QCOL_BLOCK - NA_WIN_COLS // 2, 0, GRID_W - NA_KCOL_BLOCK)
    k_cols = kblk_start[:, None] + jnp.arange(NA_KCOL_BLOCK)
    kc = k_cols[:, None, :]
    col_in = (kc >= win_start[..., None]) & (kc < win_start[..., None] + NA_WIN_COLS)
    col_off = jnp.clip(kc - q_cols[..., None] + NA_WIN_COLS - 1, 0, 2 * NA_WIN_COLS - 2)
    mask = jnp.broadcast_to(col_in[:, :, None, :], (n_cb, NA_QCOL_BLOCK, wr, NA_KCOL_BLOCK))
    mask = mask.reshape(n_cb, NA_QCOL_BLOCK, n_loc)
    scale = dh ** -0.5

    def one_row(args):
        q_row, r, r0 = args
        k_band = lax.dynamic_slice_in_dim(kg, r0, wr, axis=1)[:, :, k_cols]
        v_band = lax.dynamic_slice_in_dim(vg, r0, wr, axis=1)[:, :, k_cols]
        k_blk = k_band.transpose(0, 4, 2, 1, 3, 5).reshape(B, H, n_cb, n_loc, dh)
        v_blk = v_band.transpose(0, 4, 2, 1, 3, 5).reshape(B, H, n_cb, n_loc, dh)
        q_blk = q_row.reshape(B, n_cb, NA_QCOL_BLOCK, H, dh).transpose(0, 3, 1, 2, 4)
        row_off = r0 + jnp.arange(wr) - r + NA_WIN_ROWS - 1
        bias = rpb[:, row_off][:, :, col_off]
        bias = bias.transpose(0, 2, 3, 1, 4).reshape(H, n_cb, NA_QCOL_BLOCK, n_loc).astype(jnp.float32)
        s_loc = jnp.einsum('bhnqd,bhnkd->bhnqk', q_blk, k_blk).astype(jnp.float32) * scale + bias
        s_loc = jnp.where(mask, s_loc, -jnp.inf)
        s_ctx = jnp.einsum('bhnqd,bhcd->bhnqc', q_blk, k_ctx).astype(jnp.float32) * scale
        p = jax.nn.softmax(jnp.concatenate([s_loc, s_ctx], axis=-1), axis=-1).astype(v.dtype)
        o = (jnp.einsum('bhnqk,bhnkd->bhnqd', p[..., :n_loc], v_blk)
             + jnp.einsum('bhnqc,bhcd->bhnqd', p[..., n_loc:], v_ctx))
        return o.transpose(0, 2, 3, 1, 4).reshape(B, GRID_W, H, dh)

    out = lax.map(one_row, (jnp.moveaxis(qg, 1, 0), q_rows, row_start))
    return jnp.moveaxis(out, 0, 1).reshape(B, T, H, dh)


def hybrid_mixer(xc, xl, w_in, w_out, conv_w, conv_b, w_a, b_a, w_x, b_x, lam,
                 q_norm, w_uq, kv_norm, w_ukv, mq_gain, mk_gain, nq_gain, nk_gain, rpb,
                 cos, sin, need_ctx):
    B, C, _ = xc.shape
    T = xl.shape[1]
    c_lx, c_lg, c_cq, c_ckv, c_kr, c_nq, c_nk, c_nv = split_columns(xc @ w_in)
    l_lx, l_lg, l_cq, l_ckv, l_kr, l_nq, l_nk, l_nv = split_columns(xl @ w_in)

    yc_lru, yl_lru = bidir_rglru(depthwise_conv(c_lx, conv_w, conv_b), depthwise_conv(l_lx, conv_w, conv_b),
                                 w_a, b_a, w_x, b_x, lam, need_ctx)
    yl_lru = yl_lru * jax.nn.gelu(l_lg)

    kc_m, vc_m = mla_keys_values(c_ckv, c_kr, kv_norm, w_ukv, mk_gain)
    kl_m, vl_m = mla_keys_values(l_ckv, l_kr, kv_norm, w_ukv, mk_gain, cos, sin)
    ql_m = mla_queries(l_cq, q_norm, w_uq, mq_gain, cos, sin)
    yl_mla = blocked_attention(ql_m, jnp.concatenate([kc_m, kl_m], axis=2), jnp.concatenate([vc_m, vl_m], axis=2))
    yl_mla = yl_mla.transpose(0, 2, 1, 3).reshape(B, T, MLA_HEADS * MLA_V)

    kc_n = rms_norm(c_nk.reshape(B, C, NA_HEADS, NA_HEAD_DIM), nk_gain).transpose(0, 2, 1, 3)
    vc_n = c_nv.reshape(B, C, NA_HEADS, NA_HEAD_DIM).transpose(0, 2, 1, 3)
    ql_n = rms_norm(l_nq.reshape(B, T, NA_HEADS, NA_HEAD_DIM), nq_gain)
    kl_n = rms_norm(l_nk.reshape(B, T, NA_HEADS, NA_HEAD_DIM), nk_gain)
    vl_n = l_nv.reshape(B, T, NA_HEADS, NA_HEAD_DIM)
    yl_na = neighborhood_attention(ql_n, kl_n, vl_n, kc_n, vc_n, rpb).reshape(B, T, NA_WIDTH)

    yl = jnp.concatenate([yl_lru, yl_mla, yl_na], axis=-1) @ w_out
    if not need_ctx:
        return None, yl
    yc_lru = yc_lru * jax.nn.gelu(c_lg)
    qc_m = mla_queries(c_cq, q_norm, w_uq, mq_gain)
    yc_mla = attention(qc_m, kc_m, vc_m).transpose(0, 2, 1, 3).reshape(B, C, MLA_HEADS * MLA_V)
    qc_n = rms_norm(c_nq.reshape(B, C, NA_HEADS, NA_HEAD_DIM), nq_gain).transpose(0, 2, 1, 3)
    yc_na = attention(qc_n, kc_n, vc_n).transpose(0, 2, 1, 3).reshape(B, C, NA_WIDTH)
    yc = jnp.concatenate([yc_lru, yc_mla, yc_na], axis=-1) @ w_out
    return yc, yl


def setup_inputs(seed: int = 0) -> dict:
    key = jax.random.key(seed)
    ks = iter(jax.random.split(key, 40))

    def normal(shape, scale):
        return jax.random.normal(next(ks), shape, jnp.float32) * scale

    def gain(shape):
        return 1.0 + normal(shape, 0.01)

    u = jax.random.uniform(next(ks), (DEPTH, 2, LRU_WIDTH), jnp.float32, minval=0.9, maxval=0.999)
    return {
        'x': normal((BATCH, SEQ, D_MODEL), 1.0),
        'c': normal((BATCH, D_MODEL), 1.0),
        'ctx': normal((BATCH, CTX_LEN, D_MODEL), 1.0),
        'c_ctx': normal((D_MODEL,), 1.0),
        'w_mod': normal((DEPTH, D_MODEL, MOD_CHUNKS * D_MODEL), 0.5 * D_MODEL ** -0.5),
        'b_mod': normal((DEPTH, MOD_CHUNKS * D_MODEL), 0.01),
        'norm_ffn1': gain((DEPTH, D_MODEL)),
        'ffn1_w_in': normal((DEPTH, D_MODEL, 2 * D_FF), D_MODEL ** -0.5),
        'ffn1_w_out': normal((DEPTH, D_FF, D_MODEL), D_FF ** -0.5),
        'norm_mix': gain((DEPTH, D_MODEL)),
        'w_in': normal((DEPTH, D_MODEL, IN_WIDTH), D_MODEL ** -0.5),
        'w_out': normal((DEPTH, MIX_WIDTH, D_MODEL), MIX_WIDTH ** -0.5),
        'lru_conv_w': normal((DEPTH, CONV_W, LRU_WIDTH), CONV_W ** -0.5),
        'lru_conv_b': normal((DEPTH, LRU_WIDTH), 0.01),
        'lru_w_a': normal((DEPTH, 2, LRU_BLOCKS, LRU_BLOCK_W, LRU_BLOCK_W), LRU_BLOCK_W ** -0.5),
        'lru_b_a': normal((DEPTH, 2, LRU_WIDTH), 0.01),
        'lru_w_x': normal((DEPTH, 2, LRU_BLOCKS, LRU_BLOCK_W, LRU_BLOCK_W), LRU_BLOCK_W ** -0.5),
        'lru_b_x': normal((DEPTH, 2, LRU_WIDTH), 0.01),
        'lru_lambda': jnp.log(u) - jnp.log1p(-u),
        'mla_q_norm': gain((DEPTH, MLA_Q_RANK)),
        'mla_w_uq': normal((DEPTH, MLA_Q_RANK, MLA_HEADS * MLA_QK_DIM), MLA_Q_RANK ** -0.5),
        'mla_kv_norm': gain((DEPTH, MLA_KV_RANK)),
        'mla_w_ukv': normal((DEPTH, MLA_KV_RANK, MLA_HEADS * (MLA_NOPE + MLA_V)), MLA_KV_RANK ** -0.5),
        'mla_q_gain': gain((DEPTH, MLA_QK_DIM)),
        'mla_k_gain': gain((DEPTH, MLA_QK_DIM)),
        'na_q_gain': gain((DEPTH, NA_HEAD_DIM)),
        'na_k_gain': gain((DEPTH, NA_HEAD_DIM)),
        'na_rpb': normal((DEPTH, NA_HEADS, 2 * NA_WIN_ROWS - 1, 2 * NA_WIN_COLS - 1), 0.5),
        'norm_ffn2': gain((DEPTH, D_MODEL)),
        'ffn2_w_in': normal((DEPTH, D_MODEL, 2 * D_FF), D_MODEL ** -0.5),
        'ffn2_w_out': normal((DEPTH, D_FF, D_MODEL), D_FF ** -0.5),
    }


def reference(x, c, ctx, c_ctx, w_mod, b_mod, norm_ffn1, ffn1_w_in, ffn1_w_out, norm_mix, w_in, w_out,
              lru_conv_w, lru_conv_b, lru_w_a, lru_b_a, lru_w_x, lru_b_x, lru_lambda,
              mla_q_norm, mla_w_uq, mla_kv_norm, mla_w_ukv, mla_q_gain, mla_k_gain,
              na_q_gain, na_k_gain, na_rpb, norm_ffn2, ffn2_w_in, ffn2_w_out):
    T = x.shape[1]
    cos, sin = axial_rope(T, x.dtype)
    h, hc = x, ctx
    for layer in range(DEPTH):
        last = layer == DEPTH - 1
        mod = jax.nn.silu(c) @ w_mod[layer] + b_mod[layer]
        mod_c = jax.nn.silu(c_ctx)[None, :] @ w_mod[layer] + b_mod[layer]
        sh1, sc1, g1, shm, scm, gm, sh2, sc2, g2 = jnp.split(mod, MOD_CHUNKS, axis=-1)
        csh1, csc1, cg1, cshm, cscm, cgm, csh2, csc2, cg2 = jnp.split(mod_c, MOD_CHUNKS, axis=-1)

        h = h + 0.5 * g1[:, None] * swiglu(modulate(rms_norm(h, norm_ffn1[layer]), sh1, sc1),
                                           ffn1_w_in[layer], ffn1_w_out[layer])
        hc = hc + 0.5 * cg1[:, None] * swiglu(modulate(rms_norm(hc, norm_ffn1[layer]), csh1, csc1),
                                              ffn1_w_in[layer], ffn1_w_out[layer])

        yc, yl = hybrid_mixer(
            modulate(rms_norm(hc, norm_mix[layer]), cshm, cscm),
            modulate(rms_norm(h, norm_mix[layer]), shm, scm),
            w_in[layer], w_out[layer], lru_conv_w[layer], lru_conv_b[layer],
            lru_w_a[layer], lru_b_a[layer], lru_w_x[layer], lru_b_x[layer], lru_lambda[layer],
            mla_q_norm[layer], mla_w_uq[layer], mla_kv_norm[layer], mla_w_ukv[layer],
            mla_q_gain[layer], mla_k_gain[layer], na_q_gain[layer], na_k_gain[layer], na_rpb[layer],
            cos, sin, not last)
        h = h + gm[:, None] * yl

        h = h + 0.5 * g2[:, None] * swiglu(modulate(rms_norm(h, norm_ffn2[layer]), sh2, sc2),
                                           ffn2_w_in[layer], ffn2_w_out[layer])
        if not last:
            hc = hc + cgm[:, None] * yc
            hc = hc + 0.5 * cg2[:, None] * swiglu(modulate(rms_norm(hc, norm_ffn2[layer]), csh2, csc2),
                                                  ffn2_w_in[layer], ffn2_w_out[layer])
    return h
```

```cpp
#include <hip/hip_runtime.h>
#include <hip/hip_cooperative_groups.h>
#include <cstdio>
#include <cstdint>
namespace cg = cooperative_groups;
namespace pg8 {
#define PG8_LAS __attribute__((address_space(3)))
typedef unsigned short bf16_t;
typedef short bf16x8 __attribute__((ext_vector_type(8)));
typedef float f32x4 __attribute__((ext_vector_type(4)));
typedef unsigned u32x4 __attribute__((ext_vector_type(4)));
constexpr int BM = 256, BK = 64, HALF = 128, HTB = HALF * BK * 2  , STAGE_BYTES = 8 * HTB, NXCD = 8, WGM = 8;

__host__ __device__ __forceinline__ int lds_byte(int r, int c) { const int st = (r >> 4) * 2 + (c >> 5), rr = r & 15, cc = c & 31, ob = rr * 64 + cc * 2; return st * 1024 + (ob ^ (((ob >> 9) & 1) << 5)); }
__host__ __device__ __forceinline__ void stage_rc(int b, int& R, int& C) { const int st = b / 1024, sb = b % 1024, swz = sb ^ (((sb >> 9) & 1) << 5); R = (st >> 1) * 16 + swz / 64; C = (st & 1) * 32 + (swz % 64) / 2; }
__host__ __device__ __forceinline__ int perm32(int rho) { const int n = rho >> 4, i = rho & 15; return 8 * (i >> 2) + 4 * n + (i & 3); }

struct Unit { int pm, pn; };
struct Gemm { const bf16_t* A; const bf16_t* Bt; int M, N, K; };

struct StaticOrder {
    int nM, nN, nwg, G, c;
    __host__ __device__ void init(int M, int N, int G_, int c_) { nM = M / BM; nN = N / BM; nwg = nM * nN; G = G_; c = c_; }
    __host__ __device__ bool next(int i, Unit& u) const {
        const long L = (long)i * G + c; if (L >= nwg) return false;
        int wgid = (int)L; { const int q = nwg / NXCD, r = nwg % NXCD, xcd = wgid % NXCD, off = wgid / NXCD; wgid = (xcd < r ? xcd * (q + 1) : r * (q + 1) + (xcd - r) * q) + off; }
        const int nig = WGM * nN, gid = wgid / nig, fm = gid * WGM, gsz = (nM - fm) < WGM ? (nM - fm) : WGM;
        u.pm = fm + ((wgid % nig) % gsz); u.pn = (wgid % nig) / gsz; return true;
    }
    __device__ __forceinline__ void a_ready(const Unit&) const {}
    __device__ __forceinline__ void done(const Unit&) const {}
};

typedef _Float16 f16x8 __attribute__((ext_vector_type(8)));
typedef _Float16 f16x2 __attribute__((ext_vector_type(2)));
__device__ __forceinline__ unsigned cvt_pk_bf16(float lo, float hi) { f16x2 v; v.x = (_Float16)lo; v.y = (_Float16)hi; return __builtin_bit_cast(unsigned, v); }

template <class Epi, class Sched, bool ALIGN_EPI = false, bool SP2 = false>
__device__ __forceinline__ void gemm_phase(PG8_LAS unsigned char* lds, const Gemm g, const Sched& S, const Epi& E, const int tid_in) {
    const int tid = tid_in;
    const int wid = __builtin_amdgcn_readfirstlane(tid >> 6), lane = tid & 63, wr = wid >> 2, wc = wid & 3, fr = lane & 15, fq = lane >> 4;
    const int K = g.K;
    unsigned voffA[2], voffB[2];
#pragma unroll
    for (int i = 0; i < 2; ++i) { int R, C; stage_rc(tid * 16 + i * 8192, R, C); const int Rb = Epi::PERM ? ((R & ~31) + perm32(R & 31)) : R;
        voffA[i] = (unsigned)(R * K + C) * 2u; voffB[i] = (unsigned)(Rb * K + C) * 2u; }
    const size_t kstep = (size_t)(BK * 2);
    const size_t hstep = (size_t)HALF * K * 2;
    const size_t tstep = 2 * hstep;
    const unsigned ldsw = (unsigned)wid * 1024u;
    const int aoff = lds_byte(wr * 64 + fr, fq * 8), boff = lds_byte(wc * 32 + fr, fq * 8);
#define PG8_SA(b, h) (((b) * 2 + (h)) * HTB)
#define PG8_SB(b, h) ((4 + (b) * 2 + (h)) * HTB)
#define PG8_STAGE(bufoff, gbase, voff) do { _Pragma("unroll") for (int _i = 0; _i < 2; ++_i) \
        __builtin_amdgcn_global_load_lds((const unsigned*)((const char*)(gbase) + (voff)[_i]), (PG8_LAS unsigned*)(lds + (bufoff) + ldsw + _i * 8192), 16, 0, 0); } while (0)
#define PG8_LDA(dst, b, h) do { _Pragma("unroll") for (int m = 0; m < 4; ++m) _Pragma("unroll") for (int k = 0; k < 2; ++k) dst[m][k] = *(const PG8_LAS bf16x8*)(lds + PG8_SA(b, h) + aoff + m * 2048 + k * 1024); } while (0)
#define PG8_LDB(dst, b, h) do { _Pragma("unroll") for (int n = 0; n < 2; ++n) _Pragma("unroll") for (int k = 0; k < 2; ++k) dst[n][k] = *(const PG8_LAS bf16x8*)(lds + PG8_SB(b, h) + boff + n * 2048 + k * 1024); } while (0)
#define PG8_MMA(ai, bj, At, Bt) do { __builtin_amdgcn_s_setprio(1); _Pragma("unroll") for (int m = 0; m < 4; ++m) _Pragma("unroll") for (int n = 0; n < 2; ++n) _Pragma("unroll") for (int k = 0; k < 2; ++k) \
        acc[ai][bj][m][n] = __builtin_amdgcn_mfma_f32_16x16x32_f16(__builtin_bit_cast(f16x8, Bt[n][k]), __builtin_bit_cast(f16x8, At[m][k]), acc[ai][bj][m][n], 0, 0, 0); __builtin_amdgcn_s_setprio(0); } while (0)
#define PG8_WAIT_V(n) asm volatile("s_waitcnt vmcnt(" #n ")" ::: "memory")
#define PG8_WAIT_L(n) asm volatile("s_waitcnt lgkmcnt(" #n ")" ::: "memory")
#define PG8_BAR __builtin_amdgcn_s_barrier()
#define PG8_SCHED __builtin_amdgcn_sched_barrier(0)
    Unit cur, nxt; int ui = 0;
    if (!S.next(0, cur)) return;
    f32x4 acc[2][2][4][2];
#pragma unroll
    for (int a = 0; a < 2; ++a)
#pragma unroll
        for (int b = 0; b < 2; ++b)
#pragma unroll
            for (int m = 0; m < 4; ++m)
#pragma unroll
                for (int n = 0; n < 2; ++n) acc[a][b][m][n] = (f32x4){0.f, 0.f, 0.f, 0.f};
    bf16x8 At[4][2], B0[2][2], B1[2][2];
#define PG8_PM(u) ((u).pm & 0xffff)
#define PG8_PN(u) ((u).pn & 0xffff)
#define PG8_NT(u) ((u).pm >> 16)
#define PG8_KB(u) ((size_t)((((u).pn >> 16) & 0xff) * ((u).pm >> 16)) * (BK * 2))
    const char* cA = (const char*)g.A + (size_t)PG8_PM(cur) * tstep + PG8_KB(cur); const char* cB = (const char*)g.Bt + (size_t)PG8_PN(cur) * tstep + PG8_KB(cur);
    S.a_ready(cur);
    if constexpr (SP2) {
        PG8_STAGE(PG8_SB(0, 0), cB, voffB); PG8_STAGE(PG8_SB(0, 1), cB + hstep, voffB); PG8_STAGE(PG8_SA(0, 0), cA, voffA); PG8_STAGE(PG8_SA(0, 1), cA + hstep, voffA);
        if (wr == 1) PG8_BAR;
        PG8_WAIT_V(2); PG8_BAR;
        PG8_STAGE(PG8_SB(1, 0), cB + kstep, voffB); PG8_STAGE(PG8_SA(1, 0), cA + kstep, voffA); PG8_STAGE(PG8_SB(1, 1), cB + hstep + kstep, voffB);
        PG8_WAIT_V(6); PG8_BAR;
    } else {
        PG8_STAGE(PG8_SB(0, 0), cB, voffB); PG8_STAGE(PG8_SA(0, 0), cA, voffA); PG8_STAGE(PG8_SB(0, 1), cB + hstep, voffB); PG8_STAGE(PG8_SA(0, 1), cA + hstep, voffA);
        if (wr == 1) PG8_BAR;
        PG8_WAIT_V(4); PG8_BAR;
        PG8_STAGE(PG8_SB(1, 0), cB + kstep, voffB); PG8_STAGE(PG8_SA(1, 0), cA + kstep, voffA); PG8_STAGE(PG8_SB(1, 1), cB + hstep + kstep, voffB);
        PG8_WAIT_V(6); PG8_BAR;
    }
    for (;;) {
        const bool has_next = S.next(ui + 1, nxt);
        const char* nA = has_next ? (const char*)g.A + (size_t)PG8_PM(nxt) * tstep + PG8_KB(nxt) : cA; const char* nB = has_next ? (const char*)g.Bt + (size_t)PG8_PN(nxt) * tstep + PG8_KB(nxt) : cB;
        const int nt = PG8_NT(cur);
        for (int t = 0; t < nt; t += 2) {
            const bool last = (t == nt - 2);
            const char* a1 = cA + (size_t)(t + 1) * kstep;
            const char* a2 = last ? nA : cA + (size_t)(t + 2) * kstep; const char* b2 = last ? nB : cB + (size_t)(t + 2) * kstep;
            const char* a3 = a2 + kstep; const char* b3 = b2 + kstep;
            if (last && has_next) S.a_ready(nxt);
            if constexpr (SP2) {
            PG8_LDB(B0, 0, 0); PG8_LDB(B1, 0, 1); PG8_SCHED; PG8_LDA(At, 0, 0); PG8_STAGE(PG8_SA(1, 1), a1 + hstep, voffA);
            PG8_WAIT_V(8); PG8_WAIT_L(0); PG8_BAR; PG8_MMA(0, 0, At, B0); PG8_MMA(0, 1, At, B1); PG8_BAR; PG8_SCHED;
            PG8_LDA(At, 0, 1); PG8_STAGE(PG8_SB(0, 0), b2, voffB); PG8_STAGE(PG8_SB(0, 1), b2 + hstep, voffB); PG8_STAGE(PG8_SA(0, 0), a2, voffA);
            PG8_WAIT_V(8); PG8_WAIT_L(0); PG8_BAR; PG8_MMA(1, 0, At, B0); PG8_MMA(1, 1, At, B1); PG8_BAR; PG8_SCHED;
            PG8_LDB(B0, 1, 0); PG8_LDB(B1, 1, 1); PG8_SCHED; PG8_LDA(At, 1, 0); PG8_STAGE(PG8_SA(0, 1), a2 + hstep, voffA);
            PG8_WAIT_V(8); PG8_WAIT_L(0); PG8_BAR; PG8_MMA(0, 0, At, B0); PG8_MMA(0, 1, At, B1); PG8_BAR; PG8_SCHED;
            PG8_LDA(At, 1, 1); PG8_STAGE(PG8_SB(1, 0), b3, voffB); PG8_STAGE(PG8_SB(1, 1), b3 + hstep, voffB); PG8_STAGE(PG8_SA(1, 0), a3, voffA);
            PG8_WAIT_V(8); PG8_WAIT_L(0); PG8_BAR; PG8_MMA(1, 0, At, B0); PG8_MMA(1, 1, At, B1); PG8_BAR; PG8_SCHED;
            } else {
            PG8_LDB(B0, 0, 0); PG8_SCHED; PG8_LDA(At, 0, 0); PG8_STAGE(PG8_SA(1, 1), a1 + hstep, voffA);
            PG8_WAIT_L(8); PG8_BAR; PG8_WAIT_L(0); PG8_MMA(0, 0, At, B0); PG8_BAR; PG8_SCHED;
            PG8_LDB(B1, 0, 1); PG8_STAGE(PG8_SB(0, 0), b2, voffB);
            PG8_BAR; PG8_WAIT_L(0); PG8_MMA(0, 1, At, B1); PG8_BAR;
            PG8_LDA(At, 0, 1); PG8_STAGE(PG8_SA(0, 0), a2, voffA);
            PG8_BAR; PG8_WAIT_L(0); PG8_MMA(1, 0, At, B0); PG8_BAR; PG8_SCHED;
            PG8_STAGE(PG8_SB(0, 1), b2 + hstep, voffB);
            PG8_WAIT_V(6); PG8_BAR; PG8_MMA(1, 1, At, B1); PG8_BAR;
            PG8_LDB(B0, 1, 0); PG8_SCHED; PG8_LDA(At, 1, 0); PG8_STAGE(PG8_SA(0, 1), a2 + hstep, voffA);
            PG8_WAIT_L(8); PG8_BAR; PG8_WAIT_L(0); PG8_MMA(0, 0, At, B0); PG8_BAR; PG8_SCHED;
            PG8_LDB(B1, 1, 1); PG8_STAGE(PG8_SB(1, 0), b3, voffB);
            PG8_BAR; PG8_WAIT_L(0); PG8_MMA(0, 1, At, B1); PG8_BAR;
            PG8_LDA(At, 1, 1); PG8_STAGE(PG8_SA(1, 0), a3, voffA);
            PG8_BAR; PG8_WAIT_L(0); PG8_MMA(1, 0, At, B0); PG8_BAR; PG8_SCHED;
            PG8_STAGE(PG8_SB(1, 1), b3 + hstep, voffB);
            PG8_WAIT_V(6); PG8_BAR; PG8_MMA(1, 1, At, B1); PG8_BAR;
            }
        }
        if constexpr (ALIGN_EPI) { if (wr == 0) PG8_BAR; }
        if constexpr (!Epi::AFTER_DRAIN) { E(acc, cur, wr, wc, fr, fq); S.done(cur); }
        if (!has_next) break;
#pragma unroll
        for (int a = 0; a < 2; ++a)
#pragma unroll
            for (int b = 0; b < 2; ++b)
#pragma unroll
                for (int m = 0; m < 4; ++m)
#pragma unroll
                    for (int n = 0; n < 2; ++n) acc[a][b][m][n] = (f32x4){0.f, 0.f, 0.f, 0.f};
        cur = nxt; cA = nA; cB = nB; ++ui;
        if constexpr (ALIGN_EPI) { if (wr == 1) PG8_BAR; }
    }
    PG8_WAIT_V(0);
    if constexpr (!ALIGN_EPI) { if (wr == 0) PG8_BAR; }
    PG8_BAR;
    if constexpr (Epi::AFTER_DRAIN) { E.fused(acc, cur, wr, wc, fr, fq, lds, wid, lane); S.done(cur); }
#undef PG8_SA
#undef PG8_SB
#undef PG8_STAGE
#undef PG8_LDA
#undef PG8_LDB
#undef PG8_MMA
#undef PG8_WAIT_V
#undef PG8_WAIT_L
#undef PG8_BAR
#undef PG8_SCHED
}
}

#define LAS __attribute__((address_space(3)))
typedef unsigned short bf16_t;
typedef short bf16x8 __attribute__((ext_vector_type(8)));
typedef float f32x4 __attribute__((ext_vector_type(4)));
typedef float f32x16 __attribute__((ext_vector_type(16)));
typedef unsigned u32x4 __attribute__((ext_vector_type(4)));
typedef unsigned u32x2 __attribute__((ext_vector_type(2)));

constexpr int NB = 4, T = 8192, C = 256, P = T + C, D = 1024, DFF = 2816, INW = 1952, DEPTH = 4;
constexpr int MLAT = NB * T, MTOT = MLAT + NB * C;
constexpr int NWAVES = 8, NTHR = 512;
constexpr float EPS = 1e-6f, LOG2E = 1.4426950408889634f;
constexpr int NCHUNK = P / 32;
constexpr int Z_LX = 0, Z_LG = 384, Z_CQ = 768, Z_CKV = 1024, Z_KR = 1152, Z_NQ = 1184, Z_NK = 1440, Z_NV = 1696;

constexpr size_t MiB = 1u << 20;
constexpr size_t OFF_MOD = 0;
constexpr size_t OFF_ROPE = 1 * MiB;
constexpr size_t OFF_BAR = 1 * MiB + 65536;
constexpr size_t OFF_LRUS = 2 * MiB;
constexpr size_t OFF_LRUC = 9 * MiB;
constexpr size_t OFF_HC = 13 * MiB;
constexpr size_t OFF_W = 18 * MiB;
constexpr size_t W_FFN1_IN = 0, W_FFN1_OUT = W_FFN1_IN + (size_t)5632 * 1024 * 2, W_FFN2_IN = W_FFN1_OUT + (size_t)1024 * 2816 * 2,
                 W_FFN2_OUT = W_FFN2_IN + (size_t)5632 * 1024 * 2, W_IN = W_FFN2_OUT + (size_t)1024 * 2816 * 2, W_OUT = W_IN + (size_t)2048 * 1024 * 2,
                 W_UQ = W_OUT + (size_t)1024 * 1024 * 2, W_UKV = W_UQ + (size_t)768 * 256 * 2, W_LRU = W_UKV + (size_t)768 * 256 * 2, W_END = W_LRU + (size_t)24 * 64 * 64 * 2;
static_assert(W_END <= 42 * MiB, "weights");
constexpr size_t OFF_XN = 60 * MiB;
constexpr size_t OFF_BIG = 126 * MiB;
constexpr size_t OFF_HFF = OFF_BIG;
constexpr size_t OFF_Z = OFF_BIG;
constexpr size_t OFF_CQN = OFF_Z + (size_t)MTOT * INW * 2;
constexpr size_t OFF_CKVN = OFF_CQN + (size_t)MTOT * 256 * 2;
constexpr size_t OFF_QRAW = OFF_CKVN + (size_t)MTOT * 256 * 2;
constexpr size_t OFF_KVRAW = OFF_QRAW + (size_t)MTOT * 576 * 2;
constexpr size_t OFF_QM = OFF_KVRAW + (size_t)MTOT * 768 * 2;
constexpr size_t OFF_KM = OFF_QM + (size_t)NB * 6 * P * 96 * 2;
constexpr size_t OFF_VMT = OFF_KM + (size_t)NB * 6 * P * 96 * 2;
constexpr size_t OFF_NQ = OFF_VMT + (size_t)NB * 6 * 64 * P * 2;
constexpr size_t OFF_NK = OFF_NQ + (size_t)NB * 4 * P * 64 * 2;
constexpr size_t OFF_NVT = OFF_NK + (size_t)NB * 4 * P * 64 * 2;
constexpr size_t WS_END = OFF_NVT + (size_t)NB * 4 * 64 * P * 2;
constexpr size_t OFF_PART = WS_END;
constexpr size_t WS_END2 = OFF_PART + (size_t)11 * 1024 * 1024 * 4;
static_assert(OFF_XN + (size_t)MTOT * 1024 * 2 <= OFF_BIG && OFF_HFF + (size_t)MTOT * DFF * 2 <= WS_END, "ws map");

constexpr int LDS_BYTES = 147456;

using pg8::f16x8; using pg8::f16x2;
__device__ __forceinline__ unsigned f2bf(float f) { return (unsigned)__builtin_bit_cast(unsigned short, (_Float16)f); }
__device__ __forceinline__ unsigned pk2(float lo, float hi) { return pg8::cvt_pk_bf16(lo, hi); }
__device__ __forceinline__ float bflo(unsigned u) { return (float)__builtin_bit_cast(f16x2, u).x; }
__device__ __forceinline__ float bfhi(unsigned u) { return (float)__builtin_bit_cast(f16x2, u).y; }
__device__ __forceinline__ float bf2f(bf16_t x) { return (float)__builtin_bit_cast(_Float16, x); }
#define MFMA32(a, b, c) __builtin_amdgcn_mfma_f32_32x32x16_f16(__builtin_bit_cast(f16x8, (a)), __builtin_bit_cast(f16x8, (b)), (c), 0, 0, 0)
template <int O> __device__ __forceinline__ float swz_xor(float x) { return __builtin_bit_cast(float, __builtin_amdgcn_ds_swizzle(__builtin_bit_cast(int, x), (O << 10) | 0x1f)); }
__device__ __forceinline__ float xhalf(float x) {
    const unsigned xb = __builtin_bit_cast(unsigned, x); auto t = __builtin_amdgcn_permlane32_swap(xb, xb, false, false);
    return __builtin_bit_cast(float, t[0] == xb ? t[1] : t[0]); }
__device__ __forceinline__ float xhalf_sum(float x) { const unsigned xb = __builtin_bit_cast(unsigned, x); auto t = __builtin_amdgcn_permlane32_swap(xb, xb, false, false);
    return __builtin_bit_cast(float, (unsigned)t[0]) + __builtin_bit_cast(float, (unsigned)t[1]); }
__device__ __forceinline__ float xhalf_max(float x) { const unsigned xb = __builtin_bit_cast(unsigned, x); auto t = __builtin_amdgcn_permlane32_swap(xb, xb, false, false);
    return fmaxf(__builtin_bit_cast(float, (unsigned)t[0]), __builtin_bit_cast(float, (unsigned)t[1])); }
template <int CTRL> __device__ __forceinline__ float dppf(float x) { return __builtin_bit_cast(float, __builtin_amdgcn_mov_dpp(__builtin_bit_cast(int, x), CTRL, 0xf, 0xf, true)); }
__device__ __forceinline__ float row16_sum(float v) { v += dppf<0xB1>(v); v += dppf<0x4E>(v); v += dppf<0x141>(v); v += dppf<0x140>(v); return v; }
__device__ __forceinline__ float wave_sum(float v) {
    v = row16_sum(v);
    { const unsigned xb = __builtin_bit_cast(unsigned, v); auto t = __builtin_amdgcn_permlane16_swap(xb, xb, false, false); v = __builtin_bit_cast(float, (unsigned)t[0]) + __builtin_bit_cast(float, (unsigned)t[1]); }
    return xhalf_sum(v);
}
__device__ __forceinline__ float sigmoidf_(float x) { return __builtin_amdgcn_rcpf(1.f + __expf(-x)); }
__device__ __forceinline__ int clampi(int v, int lo, int hi) { return v < lo ? lo : (v > hi ? hi : v); }
#define LDS_WAIT() asm volatile("s_waitcnt lgkmcnt(0)" ::: "memory")

struct EpiStore {
    static constexpr bool PERM = true, AFTER_DRAIN = false;
    bf16_t* O; int ldc; int ncols;
    __device__ __forceinline__ void operator()(const pg8::f32x4 (&acc)[2][2][4][2], const pg8::Unit& uu, int wr, int wc, int fr, int fq) const {
        asm volatile("" : "+v"(fr), "+v"(fq));
        const int upm = uu.pm & 0xffff, upn = uu.pn & 0xffff, unt = uu.pm >> 16; (void)unt;
        const int row0 = upm * 256 + wr * 64 + fr, col0 = upn * 256 + wc * 32 + 8 * fq;
#pragma unroll
        for (int ai = 0; ai < 2; ++ai)
#pragma unroll
            for (int m = 0; m < 4; ++m) { bf16_t* rowp = O + (size_t)(row0 + ai * 128 + m * 16) * ldc;
#pragma unroll
                for (int bj = 0; bj < 2; ++bj) { const int col = col0 + bj * 128;
                    if (col < ncols) { const pg8::f32x4 v0 = acc[ai][bj][m][0], v1 = acc[ai][bj][m][1];
                        u32x4 w; w.x = pg8::cvt_pk_bf16(v0[0], v0[1]); w.y = pg8::cvt_pk_bf16(v0[2], v0[3]); w.z = pg8::cvt_pk_bf16(v1[0], v1[1]); w.w = pg8::cvt_pk_bf16(v1[2], v1[3]);
                        *(u32x4*)(rowp + col) = w; } } }
    }
};
struct EpiSwiGLU {
    static constexpr bool PERM = true, AFTER_DRAIN = false;
    bf16_t* O;
    __device__ __forceinline__ void operator()(const pg8::f32x4 (&acc)[2][2][4][2], const pg8::Unit& uu, int wr, int wc, int fr, int fq) const {
        asm volatile("" : "+v"(fr), "+v"(fq));
        const int upm = uu.pm & 0xffff, upn = uu.pn & 0xffff, unt = uu.pm >> 16; (void)unt;
        const int row0 = upm * 256 + wr * 64 + fr, col = upn * 128 + wc * 32 + 8 * fq;
#pragma unroll
        for (int ai = 0; ai < 2; ++ai)
#pragma unroll
            for (int m = 0; m < 4; ++m) { float o[8];
#pragma unroll
                for (int n = 0; n < 2; ++n)
#pragma unroll
                    for (int e = 0; e < 4; ++e) { const float g = acc[ai][0][m][n][e], up = acc[ai][1][m][n][e]; o[4 * n + e] = g * sigmoidf_(g) * up; }
                u32x4 w; w.x = pg8::cvt_pk_bf16(o[0], o[1]); w.y = pg8::cvt_pk_bf16(o[2], o[3]); w.z = pg8::cvt_pk_bf16(o[4], o[5]); w.w = pg8::cvt_pk_bf16(o[6], o[7]);
                *(u32x4*)(O + (size_t)(row0 + ai * 128 + m * 16) * DFF + col) = w; }
    }
};
struct EpiResid {
    static constexpr bool PERM = true, AFTER_DRAIN = false;
    float* hl; float* hc; const float* gate; float coef;
    __device__ __forceinline__ void operator()(const pg8::f32x4 (&acc)[2][2][4][2], const pg8::Unit& uu, int wr, int wc, int fr, int fq) const {
        asm volatile("" : "+v"(fr), "+v"(fq));
        const int upm = uu.pm & 0xffff, upn = uu.pn & 0xffff, unt = uu.pm >> 16; (void)unt;
        float* base; const float* g;
        if (upm < 128) { base = hl + (size_t)upm * 256 * D; g = gate + (upm >> 5) * 9216; } else { base = hc + (size_t)(upm - 128) * 256 * D; g = gate + 4 * 9216; }
        const int col0 = upn * 256 + wc * 32 + 8 * fq;
        pg8::f32x4 gv[2][2];
#pragma unroll
        for (int bj = 0; bj < 2; ++bj)
#pragma unroll
            for (int n = 0; n < 2; ++n) gv[bj][n] = *(const pg8::f32x4*)(g + col0 + bj * 128 + 4 * n) * coef;
        if (!((uu.pn >> 30) & 1)) {
#pragma unroll
            for (int ai = 0; ai < 2; ++ai)
#pragma unroll
                for (int m = 0; m < 4; ++m) { float* rowp = base + (size_t)(wr * 64 + fr + ai * 128 + m * 16) * D + col0;
#pragma unroll
                    for (int bj = 0; bj < 2; ++bj)
#pragma unroll
                        for (int n = 0; n < 2; ++n) { pg8::f32x4* p = (pg8::f32x4*)(rowp + bj * 128 + 4 * n); *p = *p + gv[bj][n] * acc[ai][bj][m][n]; } }
        } else {
            float* pb = hc + (OFF_PART - OFF_HC) / 4 + ((size_t)((uu.pn >> 16) & 0xff) * 1024 + (size_t)(upm - 128) * 256) * D;
#pragma unroll
            for (int ai = 0; ai < 2; ++ai)
#pragma unroll
                for (int m = 0; m < 4; ++m) { float* rowp = pb + (size_t)(wr * 64 + fr + ai * 128 + m * 16) * D + col0;
#pragma unroll
                    for (int bj = 0; bj < 2; ++bj)
#pragma unroll
                        for (int n = 0; n < 2; ++n) *(pg8::f32x4*)(rowp + bj * 128 + 4 * n) = gv[bj][n] * acc[ai][bj][m][n]; }
        }
    }
};

struct CtxOrder {
    int n_lat, n_ctx, nN, ksplit, ntfull, G, c;
    __device__ __forceinline__ void init(int N, int K, int G_, int c_, int nctx_panels, int ksplit_, int rev = 0) { nN = N / 256; n_lat = 128 * nN; ksplit = ksplit_ | (rev << 8); ntfull = K / 64; n_ctx = nctx_panels * nN * ksplit_; G = G_; c = c_; }
    __device__ __forceinline__ bool next(int i, pg8::Unit& u) const {
        const int L = i * G + c;
        if (L < n_lat) {
            const int wgid = (L & 7) * (n_lat >> 3) + (L >> 3), nig = 8 * nN, w = wgid % nig;
            u.pm = (((wgid / nig) ^ (ksplit >> 8)) * 8 + (w & 7)) | (ntfull << 16); u.pn = w >> 3; return true; }
        const int q = L - n_lat; if (q >= n_ctx) return false;
        const int ksp = ksplit & 0xff, ks = q % ksp, rest = q / ksp; u.pn = (rest % nN) | (ks << 16) | (ksp > 1 ? (1 << 30) : 0); u.pm = (128 + rest / nN) | ((ntfull / ksp) << 16); return true;
    }
    __device__ __forceinline__ void a_ready(const pg8::Unit&) const {}
    __device__ __forceinline__ void done(const pg8::Unit&) const {}
};

template <int MODE> __device__ __forceinline__ int dest_row(int n0) {
    if (MODE == 1) { const int g = n0 >= DFF ? 1 : 0; const int nn = n0 - g * DFF; return (nn >> 7) * 256 + g * 128 + (nn & 127); }
    return n0;
}
template <int MODE> __device__ __forceinline__ void transpose_item(const float* __restrict__ W, int N, bf16_t* __restrict__ WT, int ldk, LAS float* scr, int item, int lane) {
    const int nblk = N / 32, kb = item / nblk, nb = item % nblk, k0 = 64 * kb, n0 = 32 * nb;
#pragma unroll 8
    for (int i = 0; i < 32; ++i) { const int kk = 2 * i + (lane >> 5); scr[kk * 33 + (lane & 31)] = W[(size_t)(k0 + kk) * N + n0 + (lane & 31)]; }
    LDS_WAIT();
    const int c = lane & 7, r0 = dest_row<MODE>(n0);
#pragma unroll
    for (int j = 0; j < 4; ++j) { const int n = (lane >> 3) + 8 * j; const LAS float* s = scr + (8 * c) * 33 + n;
        u32x4 o; o.x = pk2(s[0 * 33], s[1 * 33]); o.y = pk2(s[2 * 33], s[3 * 33]); o.z = pk2(s[4 * 33], s[5 * 33]); o.w = pk2(s[6 * 33], s[7 * 33]);
        *(u32x4*)(WT + (size_t)(r0 + n) * ldk + k0 + 8 * c) = o; }
    LDS_WAIT();
}

struct Args { const float* in[31]; float* out; unsigned char* ws; int ph_lo, ph_hi; };
typedef const __attribute__((address_space(4))) Args* ArgP;

__device__ __forceinline__ void convert_weights(ArgP a, int l, LAS unsigned char* lds, int gw, int NGW, int wave, int lane) {
    unsigned char* wb = a->ws + OFF_W;
    LAS float* scr = (LAS float*)(lds + wave * 16384);
    constexpr int I_FI = 16 * 176, I_FO = 44 * 32, I_WI = 16 * 61, I_WO = 16 * 32, I_UQ = 4 * 18, I_UKV = 2 * 24, I_LRU = 48;
    constexpr int NIT = 2 * I_FI + 2 * I_FO + I_WI + I_WO + I_UQ + I_UKV + I_LRU;
    for (int it = gw; it < NIT; it += NGW) {
        int r = it;
        if (r < I_FI) { transpose_item<1>(a->in[7] + (size_t)l * D * 2 * DFF, 2 * DFF, (bf16_t*)(wb + W_FFN1_IN), D, scr, r, lane); continue; } r -= I_FI;
        if (r < I_FI) { transpose_item<1>(a->in[29] + (size_t)l * D * 2 * DFF, 2 * DFF, (bf16_t*)(wb + W_FFN2_IN), D, scr, r, lane); continue; } r -= I_FI;
        if (r < I_FO) { transpose_item<0>(a->in[8] + (size_t)l * DFF * D, D, (bf16_t*)(wb + W_FFN1_OUT), DFF, scr, r, lane); continue; } r -= I_FO;
        if (r < I_FO) { transpose_item<0>(a->in[30] + (size_t)l * DFF * D, D, (bf16_t*)(wb + W_FFN2_OUT), DFF, scr, r, lane); continue; } r -= I_FO;
        if (r < I_WI) { transpose_item<0>(a->in[10] + (size_t)l * D * INW, INW, (bf16_t*)(wb + W_IN), D, scr, r, lane); continue; } r -= I_WI;
        if (r < I_WO) { transpose_item<0>(a->in[11] + (size_t)l * D * D, D, (bf16_t*)(wb + W_OUT), D, scr, r, lane); continue; } r -= I_WO;
        if (r < I_UQ) { transpose_item<0>(a->in[20] + (size_t)l * 256 * 576, 576, (bf16_t*)(wb + W_UQ), 256, scr, r, lane); continue; } r -= I_UQ;
        if (r < I_UKV) { transpose_item<0>(a->in[22] + (size_t)l * 128 * 768, 768, (bf16_t*)(wb + W_UKV), 256, scr, r, lane); continue; } r -= I_UKV;
        { const int mat = r >> 1, sub = r & 1, ax = (mat / 6) & 1, dir = mat / 12, n = mat % 6;
          const float* src = (ax ? a->in[16] : a->in[14]) + (size_t)((l * 2 + dir) * 6 + n) * 4096;
          transpose_item<0>(src, 64, (bf16_t*)(wb + W_LRU) + (size_t)mat * 4096, 64, scr, sub, lane); }
    }
    const int gt = gw * 64 + lane, GT = NGW * 64; unsigned zz = 0u; asm volatile("" : "+v"(zz)); const u32x4 z = {zz, zz, zz, zz};
    for (int i = gt; i < 12288; i += GT) *(u32x4*)(wb + W_IN + (size_t)1952 * 1024 * 2 + (size_t)i * 16) = z;
    for (int i = gt; i < 6144; i += GT) *(u32x4*)(wb + W_UQ + (size_t)576 * 256 * 2 + (size_t)i * 16) = z;
    for (int i = gt; i < 12288; i += GT) *(u32x4*)(wb + W_UKV + (size_t)(i >> 4) * 512 + 256 + (i & 15) * 16) = z;
}

__device__ __forceinline__ void p0_phase(ArgP a, LAS unsigned char* lds, int tid, int wave, int lane, int bid, int G) {
    const int gt = bid * NTHR + tid, GT = G * NTHR;
    { const f32x4* xs = (const f32x4*)a->in[0]; f32x4* xd = (f32x4*)a->out;
      for (int i = gt; i < MLAT * D / 4; i += GT) xd[i] = xs[i];
      const f32x4* cs = (const f32x4*)a->in[2]; f32x4* cd = (f32x4*)(a->ws + OFF_HC);
      for (int i = gt; i < NB * C * D / 4; i += GT) cd[i] = cs[i]; }
    if (bid == 0) {
        float* rope = (float*)(a->ws + OFF_ROPE);
        for (int i = tid; i < 1024; i += NTHR) { const int pos = i >> 3, j = i & 7;
            const float invs[8] = {1.0f, 0.31622776f, 0.1f, 0.031622775f, 0.01f, 0.0031622776f, 0.001f, 0.00031622776f};
            float inv = invs[0];
#pragma unroll
            for (int q = 1; q < 8; ++q) inv = (j == q) ? invs[q] : inv;
            const float x = (float)pos * inv;
            const float q = rintf(x * 0.63661977236758134f); const int n = (int)q;
            float rr = fmaf(-q, 1.5703125f, x); rr = fmaf(-q, 4.837512969970703125e-4f, rr); rr = fmaf(-q, 7.54978995489188216e-8f, rr);
            const float r2 = rr * rr;
            const float sr = rr + rr * r2 * (-1.6666654611e-1f + r2 * (8.3321608736e-3f + r2 * (-1.9515295891e-4f)));
            const float cr = 1.0f - 0.5f * r2 + r2 * r2 * (4.166664568298827e-2f + r2 * (-1.388731625493765e-3f + r2 * (2.443315711809948e-5f)));
            float s, c; const int qd = n & 3;
            if (qd == 0) { s = sr; c = cr; } else if (qd == 1) { s = cr; c = -sr; } else if (qd == 2) { s = -sr; c = -cr; } else { s = -cr; c = sr; }
            rope[2 * i] = c; rope[2 * i + 1] = s; }
    }
    LAS float* sl = (LAS float*)lds; LAS float* red = (LAS float*)(lds + 5 * 1024 * 4);
    for (int i = tid; i < 5 * 1024; i += NTHR) { const int mi = i >> 10, k = i & 1023; const float v = mi < 4 ? a->in[1][mi * 1024 + k] : a->in[3][k]; sl[i] = v * sigmoidf_(v); }
    __syncthreads();
    float* MOD = (float*)(a->ws + OFF_MOD);
    for (int item = bid; item < 576; item += G) {
        const int l = item / 144, n0 = (item % 144) * 64;
        const float* wp = a->in[4] + (size_t)l * 1024 * 9216 + n0 + lane;
        float ac[5] = {0.f, 0.f, 0.f, 0.f, 0.f};
#pragma unroll 8
        for (int kk = 0; kk < 128; ++kk) { const int k = wave * 128 + kk; const float wv = wp[(size_t)k * 9216];
#pragma unroll
            for (int mi = 0; mi < 5; ++mi) ac[mi] += sl[mi * 1024 + k] * wv; }
#pragma unroll
        for (int mi = 0; mi < 5; ++mi) red[(wave * 5 + mi) * 64 + lane] = ac[mi];
        __syncthreads();
        if (tid < 320) { const int mi = tid >> 6; float s = 0.f;
#pragma unroll
            for (int w = 0; w < 8; ++w) s += red[(w * 5 + mi) * 64 + lane];
            MOD[(size_t)(l * 5 + mi) * 9216 + n0 + lane] = s + a->in[5][l * 9216 + n0 + lane]; }
        __syncthreads();
    }
}

__device__ __forceinline__ void norm_phase(const float* hl, const float* hc, const float* __restrict__ g, const float* __restrict__ modl, int sh_chunk, bf16_t* XN, int gw, int NGW, int lane, int nrows, const float* part, int npieces) {
    for (int rr = gw; rr < nrows; rr += NGW) {
        const int row = nrows - 1 - rr;
        const float* xr = row < MLAT ? hl + (size_t)row * D : hc + (size_t)(row - MLAT) * D;
        const int mi = row < MLAT ? (row >> 13) : 4;
        const float* shift = modl + mi * 9216 + sh_chunk * 1024; const float* scale = shift + 1024;
        f32x4 v[4]; float s = 0.f;
#pragma unroll
        for (int j = 0; j < 4; ++j) v[j] = *(const f32x4*)(xr + 4 * lane + 256 * j);
        if (row >= MLAT && npieces > 0) {
            for (int p = 0; p < npieces; ++p) { const float* pr = part + ((size_t)p * 1024 + (row - MLAT)) * D + 4 * lane;
#pragma unroll
                for (int j = 0; j < 4; ++j) v[j] = v[j] + *(const f32x4*)(pr + 256 * j); }
#pragma unroll
            for (int j = 0; j < 4; ++j) *(f32x4*)(const_cast<float*>(xr) + 4 * lane + 256 * j) = v[j];
        }
#pragma unroll
        for (int j = 0; j < 4; ++j) s += (v[j].x * v[j].x + v[j].y * v[j].y) + (v[j].z * v[j].z + v[j].w * v[j].w);
        const float rstd = 1.f / sqrtf(wave_sum(s) * (1.f / D) + EPS);
#pragma unroll
        for (int j = 0; j < 4; ++j) { const int k = 4 * lane + 256 * j;
            const f32x4 gg = *(const f32x4*)(g + k), sc = *(const f32x4*)(scale + k), sh = *(const f32x4*)(shift + k);
            const f32x4 y = (v[j] * rstd) * gg * (sc + 1.f) + sh;
            u32x2 o; o.x = pk2(y.x, y.y); o.y = pk2(y.z, y.w);
            *(u32x2*)(XN + (size_t)row * D + k) = o; }
    }
}

struct TileGeo { int R0, b, p0, s0, seglen, latent; };
__device__ __forceinline__ TileGeo tile_geo(int tl) {
    TileGeo g; g.R0 = tl * 64; g.latent = tl < 512;
    if (g.latent) { g.b = tl >> 7; g.s0 = (tl & 127) * 64; g.p0 = 256 + g.s0; g.seglen = T; }
    else { g.b = (tl - 512) >> 2; g.s0 = ((tl - 512) & 3) * 64; g.p0 = g.s0; g.seglen = C; }
    return g;
}

constexpr int XC_STR = 388;
__device__ __forceinline__ void lru_conv_tile(ArgP a, int l, const TileGeo& g, LAS float* xc, int tid) {
    if (tid < 384) {
        const bf16_t* Z = (const bf16_t*)(a->ws + OFF_Z) + (size_t)g.R0 * INW + Z_LX + tid;
        const float* cw = a->in[12] + (size_t)l * 4 * 384 + tid;
        const float w0 = cw[0], w1 = cw[384], w2 = cw[768], w3 = cw[1152], cb = a->in[13][l * 384 + tid];
        float xm2 = (g.s0 - 2 >= 0) ? bf2f(Z[(ptrdiff_t)(-2) * INW]) : 0.f;
        float xm1 = (g.s0 - 1 >= 0) ? bf2f(Z[(ptrdiff_t)(-1) * INW]) : 0.f;
        float x0 = bf2f(Z[0]);
        for (int i0 = 0; i0 < 64; i0 += 16) {
            float xn[16];
#pragma unroll
            for (int k = 0; k < 16; ++k) xn[k] = (g.s0 + i0 + k + 1 < g.seglen) ? bf2f(Z[(ptrdiff_t)(i0 + k + 1) * INW]) : 0.f;
#pragma unroll
            for (int k = 0; k < 16; ++k) { xc[(i0 + k) * XC_STR + tid] = cb + w0 * xm2 + w1 * xm1 + w2 * x0 + w3 * xn[k]; xm2 = xm1; xm1 = x0; x0 = xn[k]; }
        }
    }
}
template <bool FINAL>
__device__ __forceinline__ void lru_tasks(ArgP a, int l, const TileGeo& g, const LAS float* xc, int wave, int lane) {
    const int r = lane & 31, h = lane >> 5;
    const bf16_t* WL = (const bf16_t*)(a->ws + OFF_W + W_LRU);
    const float2* SUMS = (const float2*)(a->ws + OFF_LRUS); const float* CARRY = (const float*)(a->ws + OFF_LRUC);
    for (int task = wave; task < 24; task += NWAVES) {
        const int sub = task / 12, cgp = task % 12, n = cgp >> 1, chalf = cgp & 1;
        const int ch = 32 * cgp + r;
        const int chunk = (g.p0 >> 5) + sub;
        bf16x8 af[4];
#pragma unroll
        for (int ks = 0; ks < 4; ++ks) { const LAS float* xp = xc + (32 * sub + r) * XC_STR + 64 * n + 16 * ks + 8 * h;
            const f32x4 v0 = *(const LAS f32x4*)xp, v1 = *(const LAS f32x4*)(xp + 4);
            u32x4 w; w.x = pk2(v0.x, v0.y); w.y = pk2(v0.z, v0.w); w.z = pk2(v1.x, v1.y); w.w = pk2(v1.z, v1.w); af[ks] = __builtin_bit_cast(bf16x8, w); }
        float xv[16];
#pragma unroll
        for (int v = 0; v < 16; ++v) xv[v] = xc[(32 * sub + (v & 3) + 8 * (v >> 2) + 4 * h) * XC_STR + ch];
        float y[16];
#pragma unroll
        for (int v = 0; v < 16; ++v) y[v] = 0.f;
#pragma unroll
        for (int dir = 0; dir < 2; ++dir) {
            f32x16 pa, px;
#pragma unroll
            for (int v = 0; v < 16; ++v) { pa[v] = 0.f; px[v] = 0.f; }
            const bf16_t* wa = WL + (size_t)((dir * 2 + 0) * 6 + n) * 4096 + (32 * chalf + r) * 64 + 8 * h;
            const bf16_t* wx = WL + (size_t)((dir * 2 + 1) * 6 + n) * 4096 + (32 * chalf + r) * 64 + 8 * h;
#pragma unroll
            for (int ks = 0; ks < 4; ++ks) { const bf16x8 ba = *(const bf16x8*)(wa + 16 * ks), bx = *(const bf16x8*)(wx + 16 * ks);
                pa = MFMA32(af[ks], ba, pa); px = MFMA32(af[ks], bx, px); }
            const float ba_ = a->in[15][(l * 2 + dir) * 384 + ch], bx_ = a->in[17][(l * 2 + dir) * 384 + ch], lam = a->in[18][(l * 2 + dir) * 384 + ch];
            const float k1 = -8.0f * LOG2E * log1pf(__expf(-lam));
            float av[16], uv[16];
#pragma unroll
            for (int v = 0; v < 16; ++v) { const float rg = sigmoidf_(pa[v] + ba_), ig = sigmoidf_(px[v] + bx_);
                const float l2 = k1 * rg, aa = __builtin_amdgcn_exp2f(l2); av[v] = aa;
                const float x2 = l2 * 1.3862943611198906f;
                const float pl = x2 * (1.f + x2 * (0.5f + x2 * (0.16666667f + x2 * (0.041666668f + x2 * (0.0083333338f + x2 * 0.0013888889f)))));
                const float om = x2 > -0.25f ? -pl : fmaf(-aa, aa, 1.0f);
                uv[v] = __builtin_amdgcn_sqrtf(om) * (ig * xv[v]); }
            float GA[4], GU[4];
#pragma unroll
            for (int q = 0; q < 4; ++q) { float A = 1.f, U = 0.f;
#pragma unroll
                for (int cc = 0; cc < 4; ++cc) { const int c2 = dir == 0 ? cc : 3 - cc; const int v = 4 * q + c2; U = av[v] * U + uv[v]; A = av[v] * A; }
                GA[q] = A; GU[q] = U; }
            float OA[4], OU[4];
#pragma unroll
            for (int q = 0; q < 4; ++q) { OA[q] = xhalf(GA[q]); OU[q] = xhalf(GU[q]); }
            float LA[8], LU[8];
#pragma unroll
            for (int q = 0; q < 4; ++q) { LA[2 * q] = h == 0 ? GA[q] : OA[q]; LU[2 * q] = h == 0 ? GU[q] : OU[q]; LA[2 * q + 1] = h == 1 ? GA[q] : OA[q]; LU[2 * q + 1] = h == 1 ? GU[q] : OU[q]; }
            if (!FINAL) {
                float A = 1.f, U = 0.f;
#pragma unroll
                for (int gg = 0; gg < 8; ++gg) { const int gi = dir == 0 ? gg : 7 - gg; U = LA[gi] * U + LU[gi]; A = LA[gi] * A; }
                if (h == 0) { float2 o; o.x = A; o.y = U; ((float2*)SUMS)[(size_t)((g.b * 2 + dir) * NCHUNK + chunk) * 384 + ch] = o; }
            } else {
                float X = CARRY[(size_t)((g.b * 2 + dir) * NCHUNK + chunk) * 384 + ch];
                float XS[8];
#pragma unroll
                for (int gg = 0; gg < 8; ++gg) { const int gi = dir == 0 ? gg : 7 - gg; XS[gi] = X; X = LA[gi] * X + LU[gi]; }
#pragma unroll
                for (int q = 0; q < 4; ++q) { float x = h == 0 ? XS[2 * q] : XS[2 * q + 1];
#pragma unroll
                    for (int cc = 0; cc < 4; ++cc) { const int c2 = dir == 0 ? cc : 3 - cc; const int v = 4 * q + c2; x = av[v] * x + uv[v]; y[v] += x; } }
            }
        }
        if (FINAL) {
            const bf16_t* Z = (const bf16_t*)(a->ws + OFF_Z); bf16_t* Y = (bf16_t*)(a->ws + OFF_XN);
#pragma unroll
            for (int v = 0; v < 16; ++v) { const int row = g.R0 + 32 * sub + (v & 3) + 8 * (v >> 2) + 4 * h;
                const float lg = bf2f(Z[(size_t)row * INW + Z_LG + ch]);
                const float ge = lg * sigmoidf_(1.5957691216057308f * (lg + 0.044715f * lg * lg * lg));
                Y[(size_t)row * D + ch] = (bf16_t)f2bf(y[v] * ge); }
        }
    }
}
__device__ __forceinline__ void lru_carry(ArgP a, int item, int lane) {
    const int bd = item / 6, ch = 64 * (item % 6) + lane, dir = bd & 1;
    const float2* S = (const float2*)(a->ws + OFF_LRUS) + (size_t)bd * NCHUNK * 384 + ch; float* Cr = (float*)(a->ws + OFF_LRUC) + (size_t)bd * NCHUNK * 384 + ch;
    float X = 0.f;
    for (int i0 = 0; i0 < NCHUNK; i0 += 8) {
        float2 s[8]; int ck[8];
#pragma unroll
        for (int j = 0; j < 8; ++j) { const int i = i0 + j;
            ck[j] = dir == 0 ? i : (i < 8 ? 7 - i : NCHUNK + 7 - i); s[j] = S[(size_t)ck[j] * 384]; }
#pragma unroll
        for (int j = 0; j < 8; ++j) { Cr[(size_t)ck[j] * 384] = X; X = s[j].x * X + s[j].y; }
    }
}

constexpr int LRU_CW_OFF = 65536, LRU_T_OFF = 73728, LRU_T_STR = 65;
template <bool FINAL>
__device__ __forceinline__ void lru_wave_phase(ArgP a, int l, LAS unsigned char* lds, int gw, int NGW, int wave, int lane, int tid) {
    LAS float* cw = (LAS float*)(lds + LRU_CW_OFF);
    for (int i = tid; i < 5 * 384; i += NTHR) cw[i] = i < 1536 ? a->in[12][l * 1536 + i] : a->in[13][l * 384 + (i - 1536)];
    __syncthreads();
    const int NWG = NGW / 12;
    if (gw < NWG * 12) {
        const int g = gw % 12, n = g >> 1, chalf = g & 1, r = lane & 31, h = lane >> 5, ch = 32 * g + r;
        const bf16_t* WL = (const bf16_t*)(a->ws + OFF_W + W_LRU); const bf16_t* Z = (const bf16_t*)(a->ws + OFF_Z);
        bf16x8 wfa[2][4], wfx[2][4]; float ba_[2], bx_[2], k1[2];
#pragma unroll
        for (int dir = 0; dir < 2; ++dir) {
            const bf16_t* wa = WL + (size_t)((dir * 2 + 0) * 6 + n) * 4096 + (32 * chalf + r) * 64 + 8 * h; const bf16_t* wx = WL + (size_t)((dir * 2 + 1) * 6 + n) * 4096 + (32 * chalf + r) * 64 + 8 * h;
#pragma unroll
            for (int ks = 0; ks < 4; ++ks) { wfa[dir][ks] = *(const bf16x8*)(wa + 16 * ks); wfx[dir][ks] = *(const bf16x8*)(wx + 16 * ks); }
            ba_[dir] = a->in[15][(l * 2 + dir) * 384 + ch]; bx_[dir] = a->in[17][(l * 2 + dir) * 384 + ch];
            k1[dir] = -8.0f * LOG2E * log1pf(__expf(-a->in[18][(l * 2 + dir) * 384 + ch]));
        }
        LAS float* Tw = (LAS float*)(lds + LRU_T_OFF) + wave * (32 * LRU_T_STR);
        const LAS float* cwl = cw + 64 * n + 8 * h;
        for (int cid = gw / 12; cid < 1056; cid += NWG) {
            int b, cs, R0, seglen, chunk;
            if (cid < 1024) { b = cid >> 8; cs = cid & 255; R0 = b * T + 32 * cs; seglen = T; chunk = 8 + cs; } else { const int q = cid - 1024; b = q >> 3; cs = q & 7; R0 = MLAT + b * C + 32 * cs; seglen = C; chunk = cs; }
            const int s0 = 32 * cs;
            bf16x8 af[4];
#pragma unroll
            for (int kp = 0; kp < 2; ++kp) {
                u32x4 ux[4][2];
#pragma unroll
                for (int t = 0; t < 4; ++t) { const int sp = s0 + r + t - 2; const bool ok = sp >= 0 && sp < seglen; const bf16_t* zr = Z + (ptrdiff_t)(R0 + r + t - 2) * INW + 64 * n + 8 * h + 32 * kp;
#pragma unroll
                    for (int k2 = 0; k2 < 2; ++k2) { u32x4 u = {0u, 0u, 0u, 0u}; if (ok) u = *(const u32x4*)(zr + 16 * k2); ux[t][k2] = u; } }
#pragma unroll
                for (int k2 = 0; k2 < 2; ++k2) { const int ks = 2 * kp + k2; float cv[8];
                    { const f32x4 b0 = *(const LAS f32x4*)(cwl + 1536 + 16 * ks), b1 = *(const LAS f32x4*)(cwl + 1536 + 16 * ks + 4);
                      cv[0] = b0.x; cv[1] = b0.y; cv[2] = b0.z; cv[3] = b0.w; cv[4] = b1.x; cv[5] = b1.y; cv[6] = b1.z; cv[7] = b1.w; }
#pragma unroll
                    for (int t = 0; t < 4; ++t) { const f32x4 w0 = *(const LAS f32x4*)(cwl + t * 384 + 16 * ks), w1 = *(const LAS f32x4*)(cwl + t * 384 + 16 * ks + 4); const u32x4 u = ux[t][k2];
                        cv[0] += w0.x * bflo(u.x); cv[1] += w0.y * bfhi(u.x); cv[2] += w0.z * bflo(u.y); cv[3] += w0.w * bfhi(u.y);
                        cv[4] += w1.x * bflo(u.z); cv[5] += w1.y * bfhi(u.z); cv[6] += w1.z * bflo(u.w); cv[7] += w1.w * bfhi(u.w); }
                    { u32x4 w; w.x = pk2(cv[0], cv[1]); w.y = pk2(cv[2], cv[3]); w.z = pk2(cv[4], cv[5]); w.w = pk2(cv[6], cv[7]); af[ks] = __builtin_bit_cast(bf16x8, w); }
                    LAS float* tp = Tw + r * LRU_T_STR + 16 * ks + 8 * h;
#pragma unroll
                    for (int j = 0; j < 8; ++j) tp[j] = cv[j];
                }
            }
            float xv[16];
#pragma unroll
            for (int v = 0; v < 16; ++v) xv[v] = Tw[((v & 3) + 8 * (v >> 2) + 4 * h) * LRU_T_STR + 32 * chalf + r];
            float y[16];
#pragma unroll
            for (int v = 0; v < 16; ++v) y[v] = 0.f;
#pragma unroll
            for (int dir = 0; dir < 2; ++dir) {
                f32x16 pa, px;
#pragma unroll
                for (int v = 0; v < 16; ++v) { pa[v] = 0.f; px[v] = 0.f; }
#pragma unroll
                for (int ks = 0; ks < 4; ++ks) { pa = MFMA32(af[ks], wfa[dir][ks], pa); px = MFMA32(af[ks], wfx[dir][ks], px); }
                float av[16], uv[16];
#pragma unroll
                for (int v = 0; v < 16; ++v) { const float rg = sigmoidf_(pa[v] + ba_[dir]), ig = sigmoidf_(px[v] + bx_[dir]);
                    const float l2 = k1[dir] * rg, aa = __builtin_amdgcn_exp2f(l2); av[v] = aa;
                    const float x2 = l2 * 1.3862943611198906f;
                    const float pl = x2 * (1.f + x2 * (0.5f + x2 * (0.16666667f + x2 * (0.041666668f + x2 * (0.0083333338f + x2 * 0.0013888889f)))));
                    const float om = x2 > -0.25f ? -pl : fmaf(-aa, aa, 1.0f);
                    uv[v] = __builtin_amdgcn_sqrtf(om) * (ig * xv[v]); }
                float GA[4], GU[4];
#pragma unroll
                for (int q = 0; q < 4; ++q) { float A = 1.f, U = 0.f;
#pragma unroll
                    for (int cc = 0; cc < 4; ++cc) { const int c2 = dir == 0 ? cc : 3 - cc; const int v = 4 * q + c2; U = av[v] * U + uv[v]; A = av[v] * A; }
                    GA[q] = A; GU[q] = U; }
                float OA[4], OU[4];
#pragma unroll
                for (int q = 0; q < 4; ++q) { OA[q] = xhalf(GA[q]); OU[q] = xhalf(GU[q]); }
                float LA[8], LU[8];
#pragma unroll
                for (int q = 0; q < 4; ++q) { LA[2 * q] = h == 0 ? GA[q] : OA[q]; LU[2 * q] = h == 0 ? GU[q] : OU[q]; LA[2 * q + 1] = h == 1 ? GA[q] : OA[q]; LU[2 * q + 1] = h == 1 ? GU[q] : OU[q]; }
                if (!FINAL) {
                    float A = 1.f, U = 0.f;
#pragma unroll
                    for (int gg = 0; gg < 8; ++gg) { const int gi = dir == 0 ? gg : 7 - gg; U = LA[gi] * U + LU[gi]; A = LA[gi] * A; }
                    if (h == 0) { float2 o; o.x = A; o.y = U; ((float2*)(a->ws + OFF_LRUS))[(size_t)((b * 2 + dir) * NCHUNK + chunk) * 384 + ch] = o; }
                } else {
                    float X = ((const float*)(a->ws + OFF_LRUC))[(size_t)((b * 2 + dir) * NCHUNK + chunk) * 384 + ch];
                    float XE[4];
#pragma unroll
                    for (int q = 0; q < 4; ++q) XE[q] = 0.f;
#pragma unroll
                    for (int gg = 0; gg < 8; ++gg) { const int gi = dir == 0 ? gg : 7 - gg; if ((gi & 1) == h) XE[gi >> 1] = X; X = LA[gi] * X + LU[gi]; }
#pragma unroll
                    for (int q = 0; q < 4; ++q) { float x = XE[q];
#pragma unroll
                        for (int cc = 0; cc < 4; ++cc) { const int c2 = dir == 0 ? cc : 3 - cc; const int v = 4 * q + c2; x = av[v] * x + uv[v]; y[v] += x; } }
                }
            }
            if (FINAL) {
#pragma unroll
                for (int v = 0; v < 16; ++v) Tw[((v & 3) + 8 * (v >> 2) + 4 * h) * LRU_T_STR + r] = y[v];
                const bf16_t* zl = Z + (size_t)(R0 + r) * INW + Z_LG + 32 * g + 16 * h;
                const u32x4 l0 = *(const u32x4*)zl, l1 = *(const u32x4*)(zl + 8);
                const unsigned lw[8] = {l0.x, l0.y, l0.z, l0.w, l1.x, l1.y, l1.z, l1.w}; unsigned ow[8];
#pragma unroll
                for (int j = 0; j < 8; ++j) { const float y0 = Tw[r * LRU_T_STR + 16 * h + 2 * j], y1 = Tw[r * LRU_T_STR + 16 * h + 2 * j + 1]; const float g0 = bflo(lw[j]), g1 = bfhi(lw[j]);
                    const float e0 = g0 * sigmoidf_(1.5957691216057308f * (g0 + 0.044715f * g0 * g0 * g0)), e1 = g1 * sigmoidf_(1.5957691216057308f * (g1 + 0.044715f * g1 * g1 * g1));
                    ow[j] = pk2(y0 * e0, y1 * e1); }
                bf16_t* yo = (bf16_t*)(a->ws + OFF_XN) + (size_t)(R0 + r) * D + 32 * g + 16 * h;
                u32x4 o0 = {ow[0], ow[1], ow[2], ow[3]}, o1 = {ow[4], ow[5], ow[6], ow[7]}; *(u32x4*)yo = o0; *(u32x4*)(yo + 8) = o1;
            }
        }
    }
    __syncthreads();
}

__device__ __forceinline__ void mixprep_rows(ArgP a, int l, int gw, int NGW, int lane) {
    const bf16_t* Z = (const bf16_t*)(a->ws + OFF_Z);
    const float* qn = a->in[19] + l * 256; const float* kvn = a->in[21] + l * 128; const float* nqg = a->in[25] + l * 64; const float* nkg = a->in[26] + l * 64;
    const float nscale = 0.125f * LOG2E;
    const f32x4 gq = *(const f32x4*)(qn + 4 * lane); const float gkv0 = kvn[2 * lane], gkv1 = kvn[2 * lane + 1];
    const int hd = lane >> 4, d0 = 4 * (lane & 15);
    const f32x4 gnq = *(const f32x4*)(nqg + d0), gnk = *(const f32x4*)(nkg + d0);
    for (int row0 = gw * 4; row0 < MTOT; row0 += NGW * 4) {
        u32x2 ucq[4], unq[4], unk[4]; unsigned uckv[4];
#pragma unroll
        for (int t4 = 0; t4 < 4; ++t4) { const bf16_t* zr = Z + (size_t)(row0 + t4) * INW;
            ucq[t4] = *(const u32x2*)(zr + Z_CQ + 4 * lane); uckv[t4] = *(const unsigned*)(zr + Z_CKV + 2 * lane);
            unq[t4] = *(const u32x2*)(zr + Z_NQ + 4 * lane); unk[t4] = *(const u32x2*)(zr + Z_NK + 4 * lane); }
#pragma unroll
        for (int t4 = 0; t4 < 4; ++t4) {
            const int row = row0 + t4; int b, p; if (row < MLAT) { b = row >> 13; p = 256 + (row & 8191); } else { b = (row - MLAT) >> 8; p = (row - MLAT) & 255; }
            { const u32x2 u = ucq[t4]; float v0 = bflo(u.x), v1 = bfhi(u.x), v2 = bflo(u.y), v3 = bfhi(u.y);
              const float rstd = 1.f / sqrtf(wave_sum(v0 * v0 + v1 * v1 + v2 * v2 + v3 * v3) * (1.f / 256) + EPS);
              u32x2 o; o.x = pk2(v0 * rstd * gq.x, v1 * rstd * gq.y); o.y = pk2(v2 * rstd * gq.z, v3 * rstd * gq.w);
              *(u32x2*)((bf16_t*)(a->ws + OFF_CQN) + (size_t)row * 256 + 4 * lane) = o; }
            { const unsigned u = uckv[t4]; float v0 = bflo(u), v1 = bfhi(u);
              const float rstd = 1.f / sqrtf(wave_sum(v0 * v0 + v1 * v1) * (1.f / 128) + EPS);
              bf16_t* o = (bf16_t*)(a->ws + OFF_CKVN) + (size_t)row * 256;
              *(unsigned*)(o + 2 * lane) = pk2(v0 * rstd * gkv0, v1 * rstd * gkv1); *(unsigned*)(o + 128 + 2 * lane) = 0u; }
            { const u32x2 u = unq[t4]; float v0 = bflo(u.x), v1 = bfhi(u.x), v2 = bflo(u.y), v3 = bfhi(u.y);
              float sq = v0 * v0 + v1 * v1 + v2 * v2 + v3 * v3; sq = row16_sum(sq);
              const float rstd = nscale / sqrtf(sq * (1.f / 64) + EPS);
              u32x2 o; o.x = pk2(v0 * rstd * gnq.x, v1 * rstd * gnq.y); o.y = pk2(v2 * rstd * gnq.z, v3 * rstd * gnq.w);
              *(u32x2*)((bf16_t*)(a->ws + OFF_NQ) + ((size_t)(b * 4 + hd) * P + p) * 64 + d0) = o; }
            { const u32x2 u = unk[t4]; float v0 = bflo(u.x), v1 = bfhi(u.x), v2 = bflo(u.y), v3 = bfhi(u.y);
              float sq = v0 * v0 + v1 * v1 + v2 * v2 + v3 * v3; sq = row16_sum(sq);
              const float rstd = 1.f / sqrtf(sq * (1.f / 64) + EPS);
              u32x2 o; o.x = pk2(v0 * rstd * gnk.x, v1 * rstd * gnk.y); o.y = pk2(v2 * rstd * gnk.z, v3 * rstd * gnk.w);
              *(u32x2*)((bf16_t*)(a->ws + OFF_NK) + ((size_t)(b * 4 + hd) * P + p) * 64 + d0) = o; }
        }
    }
}
constexpr int NVT_STR = 516;
__device__ __forceinline__ void mixprep_tile(ArgP a, int l, int tl, LAS unsigned char* lds, int tid, int wave, int lane, int pm) {
    const TileGeo g = tile_geo(tl);
    LAS unsigned char* nvt = lds;
    const bf16_t* Z = (const bf16_t*)(a->ws + OFF_Z);
    { u32x2 unv[8];
#pragma unroll
      for (int ii = 0; ii < 8; ++ii) unv[ii] = *(const u32x2*)(Z + (size_t)(g.R0 + wave * 8 + ii) * INW + Z_NV + 4 * lane);
#pragma unroll
      for (int ii = 0; ii < 8; ++ii) { const int i = wave * 8 + ii; *(LAS unsigned*)(nvt + i * NVT_STR + 8 * lane) = unv[ii].x; *(LAS unsigned*)(nvt + i * NVT_STR + 8 * lane + 4) = unv[ii].y; } }
    __syncthreads();
    {
        const int rowid = tid >> 1, half = tid & 1; unsigned w[16];
#pragma unroll
        for (int j = 0; j < 16; ++j) { const unsigned lo = *(const LAS bf16_t*)(nvt + (half * 32 + 2 * j) * NVT_STR + rowid * 2), hi = *(const LAS bf16_t*)(nvt + (half * 32 + 2 * j + 1) * NVT_STR + rowid * 2); w[j] = lo | (hi << 16); }
        bf16_t* dst = (bf16_t*)(a->ws + OFF_NVT) + ((size_t)(g.b * 4 + (rowid >> 6)) * 64 + (rowid & 63)) * P + g.p0 + 32 * half;
#pragma unroll
        for (int j = 0; j < 4; ++j) { u32x4 o = {w[4 * j], w[4 * j + 1], w[4 * j + 2], w[4 * j + 3]}; *(u32x4*)(dst + 8 * j) = o; }
    }
    __syncthreads();
}

__device__ __forceinline__ void mlapost_rows(ArgP a, int l, int gw, int NGW, int lane) {
    const bf16_t* Z = (const bf16_t*)(a->ws + OFF_Z); const bf16_t* QR = (const bf16_t*)(a->ws + OFF_QRAW); const bf16_t* KVR = (const bf16_t*)(a->ws + OFF_KVRAW);
    const float* rope = (const float*)(a->ws + OFF_ROPE);
    const float qscale = 0.10206207261596575f * LOG2E;
    const int rw = lane >> 4, c = lane & 15; const bool act = c < 12, isrope = c >= 8 && c < 12;
    const int cc = act ? c : 0;
    const f32x4 gq0 = *(const f32x4*)(a->in[23] + l * 96 + 8 * cc), gq1 = *(const f32x4*)(a->in[23] + l * 96 + 8 * cc + 4);
    const f32x4 gk0 = *(const f32x4*)(a->in[24] + l * 96 + 8 * cc), gk1 = *(const f32x4*)(a->in[24] + l * 96 + 8 * cc + 4);
    const int axis = (c >> 1) & 1, hf = c & 1;
    constexpr int NGRP = MTOT * 12 / 4;
    for (int g0 = gw * 4; g0 < NGRP; g0 += NGW * 4) {
        u32x4 uin[4];
#pragma unroll
        for (int u = 0; u < 4; ++u) { const int item = (g0 + u) * 4 + rw; const size_t row = (size_t)(item / 12); const int hq = item % 12;
            const bf16_t* src = hq < 6 ? QR + row * 576 + hq * 96 + 8 * cc : (cc < 8 ? KVR + row * 768 + (hq - 6) * 128 + 8 * cc : Z + row * INW + Z_KR + 8 * (cc - 8));
            uin[u] = *(const u32x4*)src; }
#pragma unroll
        for (int u = 0; u < 4; ++u) { const int item = (g0 + u) * 4 + rw; const int row = item / 12, hq = item % 12; const bool isq = hq < 6; const int hh = isq ? hq : hq - 6;
            int b, p, t; const bool latent = row < MLAT;
            if (latent) { b = row >> 13; t = row & 8191; p = 256 + t; } else { b = (row - MLAT) >> 8; p = (row - MLAT) & 255; t = 0; }
            float v[8]; v[0] = bflo(uin[u].x); v[1] = bfhi(uin[u].x); v[2] = bflo(uin[u].y); v[3] = bfhi(uin[u].y); v[4] = bflo(uin[u].z); v[5] = bfhi(uin[u].z); v[6] = bflo(uin[u].w); v[7] = bfhi(uin[u].w);
            float ss = 0.f;
#pragma unroll
            for (int j = 0; j < 8; ++j) ss += v[j] * v[j];
            ss = act ? ss : 0.f;
            const float rstd = 1.f / sqrtf(row16_sum(ss) * (1.f / 96) + EPS);
            const f32x4 ga = isq ? gq0 : gk0, gb = isq ? gq1 : gk1;
            v[0] *= rstd * ga.x; v[1] *= rstd * ga.y; v[2] *= rstd * ga.z; v[3] *= rstd * ga.w; v[4] *= rstd * gb.x; v[5] *= rstd * gb.y; v[6] *= rstd * gb.z; v[7] *= rstd * gb.w;
            float o[8];
#pragma unroll
            for (int j = 0; j < 8; ++j) o[j] = dppf<0xB1>(v[j]);
            if (latent && isrope) { const int pos = axis == 0 ? (t >> 6) : (t & 63); const float* rp = rope + pos * 16;
                const f32x4 r0 = *(const f32x4*)rp, r1 = *(const f32x4*)(rp + 4), r2 = *(const f32x4*)(rp + 8), r3 = *(const f32x4*)(rp + 12);
                const float cs[8] = {r0.x, r0.z, r1.x, r1.z, r2.x, r2.z, r3.x, r3.z}, sn[8] = {r0.y, r0.w, r1.y, r1.w, r2.y, r2.w, r3.y, r3.w};
#pragma unroll
                for (int j = 0; j < 8; ++j) v[j] = hf == 0 ? v[j] * cs[j] - o[j] * sn[j] : v[j] * cs[j] + o[j] * sn[j]; }
            const float sc = isq ? qscale : 1.0f;
            u32x4 w; w.x = pk2(v[0] * sc, v[1] * sc); w.y = pk2(v[2] * sc, v[3] * sc); w.z = pk2(v[4] * sc, v[5] * sc); w.w = pk2(v[6] * sc, v[7] * sc);
            bf16_t* dst = (bf16_t*)(a->ws + (isq ? OFF_QM : OFF_KM)) + ((size_t)(b * 6 + hh) * P + p) * 96 + 8 * cc;
            if (act) *(u32x4*)dst = w; }
    }
}
constexpr int MVT_STR = 784;
__device__ __forceinline__ void mlapost_tile(ArgP a, int l, int tl, LAS unsigned char* lds, int tid, int wave, int lane, int pm) {
    const TileGeo g = tile_geo(tl);
    const bf16_t* KVR = (const bf16_t*)(a->ws + OFF_KVRAW);
    { u32x4 uv[6];
#pragma unroll
      for (int k = 0; k < 6; ++k) { const int idx = tid + k * NTHR, tok = idx / 48, ch = idx % 48; uv[k] = *(const u32x4*)(KVR + (size_t)(g.R0 + tok) * 768 + (ch >> 3) * 128 + 64 + (ch & 7) * 8); }
#pragma unroll
      for (int k = 0; k < 6; ++k) { const int idx = tid + k * NTHR, tok = idx / 48, ch = idx % 48; *(LAS u32x4*)(lds + tok * MVT_STR + ch * 16) = uv[k]; } }
    __syncthreads();
    for (int rowid = tid >> 1; rowid < 384; rowid += 256) { const int half = tid & 1; unsigned w[16];
#pragma unroll
        for (int j = 0; j < 16; ++j) { const unsigned lo = *(const LAS bf16_t*)(lds + (half * 32 + 2 * j) * MVT_STR + rowid * 2), hi = *(const LAS bf16_t*)(lds + (half * 32 + 2 * j + 1) * MVT_STR + rowid * 2); w[j] = lo | (hi << 16); }
        bf16_t* dst = (bf16_t*)(a->ws + OFF_VMT) + ((size_t)(g.b * 6 + rowid / 64) * 64 + (rowid & 63)) * P + g.p0 + 32 * half;
#pragma unroll
        for (int j = 0; j < 4; ++j) { u32x4 o = {w[4 * j], w[4 * j + 1], w[4 * j + 2], w[4 * j + 3]}; *(u32x4*)(dst + 8 * j) = o; }
    }
    __syncthreads();
}

__device__ __forceinline__ float max3f(float a, float b, float c) { float r; asm("v_max3_f32 %0, %1, %2, %3" : "=v"(r) : "v"(a), "v"(b), "v"(c)); return r; }
__device__ __forceinline__ unsigned pkrtz(float lo, float hi) { return __builtin_bit_cast(unsigned, __builtin_amdgcn_cvt_pkrtz(lo, hi)); }
template <bool NA>
__device__ __forceinline__ void att_softmax_pv(f32x16& S0, f32x16& S1, const float mref, f32x16& O0, f32x16& O1, f32x16& O2, float& mrun, const LAS unsigned char* vb, int r, int h, bool local, const LAS float* bp, int wst) {
    if (NA && local) {
#pragma unroll
        for (int v = 0; v < 16; ++v) { const int kc0 = 16 * (v >> 3) + 8 * h + (v & 7), kc1 = kc0 + 32;
            S0[v] = (kc0 >= wst && kc0 < wst + 16) ? S0[v] + bp[kc0] : -INFINITY; S1[v] = (kc1 >= wst && kc1 < wst + 16) ? S1[v] + bp[kc1] : -INFINITY; }
    }
    float mx = max3f(S0[0], S0[1], S0[2]);
    mx = max3f(mx, S0[3], S0[4]); mx = max3f(mx, S0[5], S0[6]); mx = max3f(mx, S0[7], S0[8]); mx = max3f(mx, S0[9], S0[10]); mx = max3f(mx, S0[11], S0[12]); mx = max3f(mx, S0[13], S0[14]);
    mx = max3f(mx, S0[15], S1[0]); mx = max3f(mx, S1[1], S1[2]); mx = max3f(mx, S1[3], S1[4]); mx = max3f(mx, S1[5], S1[6]); mx = max3f(mx, S1[7], S1[8]); mx = max3f(mx, S1[9], S1[10]);
    mx = max3f(mx, S1[11], S1[12]); mx = max3f(mx, S1[13], S1[14]); mx = fmaxf(mx, S1[15]);
    mx = xhalf_max(mx);
    const float mabs = mref + mx;
    if (__builtin_amdgcn_ballot_w64((mref != mrun) || ((mabs - mrun) > 8.0f)) != 0ull) {
        const float mnew = fmaxf(mrun, mabs), alpha = __builtin_amdgcn_exp2f(mrun - mnew), d = mnew - mref; mrun = mnew;
#pragma unroll
        for (int v = 0; v < 16; ++v) { O0[v] *= alpha; O1[v] *= alpha; O2[v] *= alpha; S0[v] -= d; S1[v] -= d; }
    }
    bf16x8 pf[4];
    { float e0[16], e1[16];
#pragma unroll
      for (int v = 0; v < 16; ++v) { e0[v] = __builtin_amdgcn_exp2f(S0[v]); e1[v] = __builtin_amdgcn_exp2f(S1[v]); }
      u32x4 w;
      w.x = pkrtz(e0[0], e0[1]); w.y = pkrtz(e0[2], e0[3]); w.z = pkrtz(e0[4], e0[5]); w.w = pkrtz(e0[6], e0[7]); pf[0] = __builtin_bit_cast(bf16x8, w);
      w.x = pkrtz(e0[8], e0[9]); w.y = pkrtz(e0[10], e0[11]); w.z = pkrtz(e0[12], e0[13]); w.w = pkrtz(e0[14], e0[15]); pf[1] = __builtin_bit_cast(bf16x8, w);
      w.x = pkrtz(e1[0], e1[1]); w.y = pkrtz(e1[2], e1[3]); w.z = pkrtz(e1[4], e1[5]); w.w = pkrtz(e1[6], e1[7]); pf[2] = __builtin_bit_cast(bf16x8, w);
      w.x = pkrtz(e1[8], e1[9]); w.y = pkrtz(e1[10], e1[11]); w.z = pkrtz(e1[12], e1[13]); w.w = pkrtz(e1[14], e1[15]); pf[3] = __builtin_bit_cast(bf16x8, w); }
    const bf16x8 ones = {0x3C00, 0x3C00, 0x3C00, 0x3C00, 0x3C00, 0x3C00, 0x3C00, 0x3C00};
#pragma unroll
    for (int kk = 0; kk < 4; ++kk) { const bf16x8 v0 = *(const LAS bf16x8*)(vb + r * 144 + kk * 32 + h * 16), v1 = *(const LAS bf16x8*)(vb + (32 + r) * 144 + kk * 32 + h * 16);
        O0 = MFMA32(v0, pf[kk], O0); O1 = MFMA32(v1, pf[kk], O1); O2 = MFMA32(ones, pf[kk], O2); }
}
template <int DQK, bool NA>
__device__ __forceinline__ void attn_unit(LAS unsigned char* lds, const bf16_t* __restrict__ Qb, const bf16_t* __restrict__ Kb, const bf16_t* __restrict__ Vtb,
                                          bf16_t* __restrict__ Yb  , int qb, const LAS float* rpbh, int tid) {
    constexpr int KSTR = (DQK + 8) * 2, VSTR = 144, KBUF = 64 * KSTR, VBUF = 64 * VSTR, KPR = DQK / 8, NKP = 64 * KPR, NKS = DQK / 16;
    static_assert(2 * KBUF + 2 * VBUF <= 49152, "attention LDS");
    const int wave = tid >> 6, lane = tid & 63, r = lane & 31, h = lane >> 5;
    int n_tiles, rlo = 0;
    if (qb == 0) n_tiles = 4;
    else if (!NA) n_tiles = P / 64;
    else { const int R = 4 * (qb - 1); rlo = clampi(R - 4, 0, 120); const int rhi = clampi(R - 1, 0, 120) + 7; n_tiles = 4 + rhi - rlo + 1; }
    const int wrow = 4 * (qb - 1) + (wave >> 1);
    const int r0w = clampi(wrow - 4, 0, 120);
    const int qc = 32 * (wave & 1) + r, wst = clampi(qc - 8, 0, 48);
    const int pq = 256 * qb + 32 * wave + r;
    bf16x8 qf[NKS];
#pragma unroll
    for (int ks = 0; ks < NKS; ++ks) qf[ks] = *(const bf16x8*)(Qb + (size_t)pq * DQK + 16 * ks + 8 * h);
    f32x16 O0, O1, O2;
#pragma unroll
    for (int v = 0; v < 16; ++v) { O0[v] = 0.f; O1[v] = 0.f; O2[v] = 0.f; }
    float mrun = -1e30f;
    const int krow = (r & ~12) | ((r & 4) << 1) | ((r & 8) >> 1);
#define ATT_TILE(it) ((NA && (it) >= 4) ? 4 + rlo + ((it) - 4) : (it))
#define ATT_ACT(it) (!(NA && (it) >= 4) || ((rlo + (it) - 4) >= r0w && (rlo + (it) - 4) <= r0w + 7))
#define ATT_LOADK(it, K0_, K1_) do { const bf16_t* kp_ = Kb + (size_t)ATT_TILE(it) * 64 * DQK; K0_ = *(const u32x4*)(kp_ + tid * 8); \
        if (NKP > 512) { if (tid < NKP - 512) K1_ = *(const u32x4*)(kp_ + (tid + 512) * 8); } } while (0)
#define ATT_LOADV(it, V_) do { V_ = *(const u32x4*)(Vtb + (size_t)(tid >> 3) * P + ATT_TILE(it) * 64 + (tid & 7) * 8); } while (0)
#define ATT_STOREK(slot, K0_, K1_) do { LAS unsigned char* bb_ = lds + (slot) * KBUF; *(LAS u32x4*)(bb_ + (tid / KPR) * KSTR + (tid % KPR) * 16) = K0_; \
        if (NKP > 512) { if (tid < NKP - 512) { const int i_ = tid + 512; *(LAS u32x4*)(bb_ + (i_ / KPR) * KSTR + (i_ % KPR) * 16) = K1_; } } } while (0)
#define ATT_STOREV(slot, V_) do { *(LAS u32x4*)(lds + 2 * KBUF + (slot) * VBUF + (tid >> 3) * VSTR + (tid & 7) * 16) = V_; } while (0)
#define ATT_QK(Sa, Sb, slot, mref_) do { const LAS unsigned char* kb_ = lds + (slot) * KBUF; const float ni_ = -(mref_); _Pragma("unroll") for (int v = 0; v < 16; ++v) { Sa[v] = ni_; Sb[v] = ni_; } \
        _Pragma("unroll") for (int ks = 0; ks < NKS; ++ks) { const bf16x8 a0 = *(const LAS bf16x8*)(kb_ + krow * KSTR + ks * 32 + h * 16), a1 = *(const LAS bf16x8*)(kb_ + (32 + krow) * KSTR + ks * 32 + h * 16); \
            Sa = MFMA32(a0, qf[ks], Sa); Sb = MFMA32(a1, qf[ks], Sb); } } while (0)
#define ATT_BODY(it, C0, C1, mrefC, N0, N1, mrefN, LK0, LK1, LV, SK0, SK1, SV) do { \
        if ((it) + 3 < n_tiles) ATT_LOADK((it) + 3, LK0, LK1); \
        if ((it) + 2 < n_tiles) ATT_LOADV((it) + 2, LV); \
        mrefN = (it) == 0 ? 0.f : mrun;                                \
        if (!NA || ((it) + 1 < n_tiles && ATT_ACT((it) + 1))) ATT_QK(N0, N1, ((it) + 1) & 1, mrefN);     \
        if (ATT_ACT(it)) { const int kr_ = rlo + (it) - 4; \
            att_softmax_pv<NA>(C0, C1, mrefC, O0, O1, O2, mrun, lds + 2 * KBUF + ((it) & 1) * VBUF, r, h, NA && (it) >= 4, rpbh + (kr_ - wrow + 7) * 31 + 15 - qc, wst); } \
        if ((it) + 2 < n_tiles) ATT_STOREK((it) & 1, SK0, SK1); \
        if ((it) + 1 < n_tiles) ATT_STOREV(((it) + 1) & 1, SV); \
        __syncthreads(); } while (0)
    u32x4 ka0, ka1 = {0u, 0u, 0u, 0u}, va, kb0, kb1 = {0u, 0u, 0u, 0u}, vb;
    ATT_LOADK(0, ka0, ka1); ATT_LOADV(0, va); ATT_LOADK(1, kb0, kb1);
    ATT_STOREK(0, ka0, ka1); ATT_STOREV(0, va); ATT_STOREK(1, kb0, kb1);
    ATT_LOADK(2, kb0, kb1); ATT_LOADV(1, vb);
    __syncthreads();
    f32x16 A0, A1, B0, B1; float mrefA = 0.f, mrefB = 0.f;
    ATT_QK(A0, A1, 0, mrefA);
    for (int it = 0; it < n_tiles; it += 2) {
        ATT_BODY(it, A0, A1, mrefA, B0, B1, mrefB, ka0, ka1, va, kb0, kb1, vb);
        if (it + 1 < n_tiles) ATT_BODY(it + 1, B0, B1, mrefB, A0, A1, mrefA, kb0, kb1, vb, ka0, ka1, va);
    }
#undef ATT_TILE
#undef ATT_ACT
#undef ATT_LOADK
#undef ATT_LOADV
#undef ATT_STOREK
#undef ATT_STOREV
#undef ATT_QK
#undef ATT_BODY
    const float inv = 1.f / O2[0];
    bf16_t* yr = Yb + (size_t)(32 * wave + r) * D;
#pragma unroll
    for (int q = 0; q < 4; ++q) { u32x2 o;
        o.x = pg8::cvt_pk_bf16(O0[4 * q] * inv, O0[4 * q + 1] * inv); o.y = pg8::cvt_pk_bf16(O0[4 * q + 2] * inv, O0[4 * q + 3] * inv); *(u32x2*)(yr + 8 * q + 4 * h) = o;
        o.x = pg8::cvt_pk_bf16(O1[4 * q] * inv, O1[4 * q + 1] * inv); o.y = pg8::cvt_pk_bf16(O1[4 * q + 2] * inv, O1[4 * q + 3] * inv); *(u32x2*)(yr + 32 + 8 * q + 4 * h) = o; }
}

__device__ __forceinline__ void att64_softmax(f32x16& S0, f32x16& S1, f32x16& O0, f32x16& O1, float& mrun, float& lsum, bf16x8 (&pf)[4], const bool first) {
    float mx = max3f(S0[0], S0[1], S0[2]);
    mx = max3f(mx, S0[3], S0[4]); mx = max3f(mx, S0[5], S0[6]); mx = max3f(mx, S0[7], S0[8]); mx = max3f(mx, S0[9], S0[10]); mx = max3f(mx, S0[11], S0[12]); mx = max3f(mx, S0[13], S0[14]);
    mx = max3f(mx, S0[15], S1[0]); mx = max3f(mx, S1[1], S1[2]); mx = max3f(mx, S1[3], S1[4]); mx = max3f(mx, S1[5], S1[6]); mx = max3f(mx, S1[7], S1[8]); mx = max3f(mx, S1[9], S1[10]);
    mx = max3f(mx, S1[11], S1[12]); mx = max3f(mx, S1[13], S1[14]); mx = fmaxf(mx, S1[15]);
    mx = xhalf_max(mx);
    if (first || __builtin_amdgcn_ballot_w64(mx > 8.0f) != 0ull) {
        const float d = first ? mx : fmaxf(mx, 0.f), alpha = first ? 0.f : __builtin_amdgcn_exp2f(-d); mrun += d; lsum *= alpha;
#pragma unroll
        for (int v = 0; v < 16; ++v) { O0[v] *= alpha; O1[v] *= alpha; S0[v] -= d; S1[v] -= d; }
    }
    float e0[16], e1[16]; float ps = 0.f;
#pragma unroll
    for (int v = 0; v < 16; ++v) { e0[v] = __builtin_amdgcn_exp2f(S0[v]); e1[v] = __builtin_amdgcn_exp2f(S1[v]); ps += e0[v] + e1[v]; }
    lsum += ps;
    u32x4 w;
    w.x = pkrtz(e0[0], e0[1]); w.y = pkrtz(e0[2], e0[3]); w.z = pkrtz(e0[4], e0[5]); w.w = pkrtz(e0[6], e0[7]); pf[0] = __builtin_bit_cast(bf16x8, w);
    w.x = pkrtz(e0[8], e0[9]); w.y = pkrtz(e0[10], e0[11]); w.z = pkrtz(e0[12], e0[13]); w.w = pkrtz(e0[14], e0[15]); pf[1] = __builtin_bit_cast(bf16x8, w);
    w.x = pkrtz(e1[0], e1[1]); w.y = pkrtz(e1[2], e1[3]); w.z = pkrtz(e1[4], e1[5]); w.w = pkrtz(e1[6], e1[7]); pf[2] = __builtin_bit_cast(bf16x8, w);
    w.x = pkrtz(e1[8], e1[9]); w.y = pkrtz(e1[10], e1[11]); w.z = pkrtz(e1[12], e1[13]); w.w = pkrtz(e1[14], e1[15]); pf[3] = __builtin_bit_cast(bf16x8, w);
}
__device__ __forceinline__ void attn_unit_mla64(LAS unsigned char* lds, const bf16_t* __restrict__ Qb, const bf16_t* __restrict__ Kb, const bf16_t* __restrict__ Vtb, bf16_t* __restrict__ Yb  , int qb, int tid_in) {
    constexpr int DQK = 96, KSTR = 208, VSTR = 144, KBUF = 64 * KSTR, VBUF = 64 * VSTR, NKS = 6;
    int tid = tid_in; asm volatile("" : "+v"(tid));
    const int wave = tid >> 6, lane = tid & 63, r = lane & 31, h = lane >> 5;
    constexpr int n_tiles = P / 64;
    const int pq = 256 + 512 * qb + 64 * wave + r;
    bf16x8 qa[NKS], qc[NKS];
#pragma unroll
    for (int ks = 0; ks < NKS; ++ks) { qa[ks] = *(const bf16x8*)(Qb + (size_t)pq * DQK + 16 * ks + 8 * h); qc[ks] = *(const bf16x8*)(Qb + (size_t)(pq + 32) * DQK + 16 * ks + 8 * h); }
    f32x16 Oa0, Oa1, Oc0, Oc1;
#pragma unroll
    for (int v = 0; v < 16; ++v) { Oa0[v] = 0.f; Oa1[v] = 0.f; Oc0[v] = 0.f; Oc1[v] = 0.f; }
    float mra = -1e30f, mrc = -1e30f, lsa = 0.f, lsc = 0.f;
    const int krow = (r & ~12) | ((r & 4) << 1) | ((r & 8) >> 1);
    u32x4 k0, k1 = {0u, 0u, 0u, 0u}, vv;
#define A6_LOAD(it) do { const bf16_t* kp_ = Kb + (size_t)(it) * 64 * DQK; k0 = *(const u32x4*)(kp_ + tid * 8); if (tid < 256) k1 = *(const u32x4*)(kp_ + (tid + 512) * 8); \
        vv = *(const u32x4*)(Vtb + (size_t)(tid >> 3) * P + (it) * 64 + (tid & 7) * 8); } while (0)
#define A6_STORE(slot) do { LAS unsigned char* bb_ = lds + (slot) * KBUF; *(LAS u32x4*)(bb_ + (tid / 12) * KSTR + (tid % 12) * 16) = k0; \
        if (tid < 256) { const int i_ = tid + 512; *(LAS u32x4*)(bb_ + (i_ / 12) * KSTR + (i_ % 12) * 16) = k1; } \
        *(LAS u32x4*)(lds + 2 * KBUF + (slot) * VBUF + (tid >> 3) * VSTR + (tid & 7) * 16) = vv; } while (0)
    A6_LOAD(0); A6_STORE(0);
    __syncthreads();
    for (int it = 0; it < n_tiles; ++it) {
        if (it + 1 < n_tiles) A6_LOAD(it + 1);
        const LAS unsigned char* kb_ = lds + (it & 1) * KBUF; const LAS unsigned char* vb_ = lds + 2 * KBUF + (it & 1) * VBUF;
        f32x16 Sa0, Sa1, Sc0, Sc1;
        { const float na = it == 0 ? 0.f : -mra, nc = it == 0 ? 0.f : -mrc;
#pragma unroll
          for (int v = 0; v < 16; ++v) { Sa0[v] = na; Sa1[v] = na; Sc0[v] = nc; Sc1[v] = nc; } }
#pragma unroll
        for (int ks = 0; ks < NKS; ++ks) { const bf16x8 a0 = *(const LAS bf16x8*)(kb_ + krow * KSTR + ks * 32 + h * 16), a1 = *(const LAS bf16x8*)(kb_ + (32 + krow) * KSTR + ks * 32 + h * 16);
            Sa0 = MFMA32(a0, qa[ks], Sa0); Sa1 = MFMA32(a1, qa[ks], Sa1); Sc0 = MFMA32(a0, qc[ks], Sc0); Sc1 = MFMA32(a1, qc[ks], Sc1); }
        if (it == 0) { mra = 0.f; mrc = 0.f; }
        bf16x8 pa[4], pc[4];
        att64_softmax(Sa0, Sa1, Oa0, Oa1, mra, lsa, pa, it == 0);
        att64_softmax(Sc0, Sc1, Oc0, Oc1, mrc, lsc, pc, it == 0);
#pragma unroll
        for (int kk = 0; kk < 4; ++kk) { const bf16x8 v0 = *(const LAS bf16x8*)(vb_ + r * VSTR + kk * 32 + h * 16), v1 = *(const LAS bf16x8*)(vb_ + (32 + r) * VSTR + kk * 32 + h * 16);
            Oa0 = MFMA32(v0, pa[kk], Oa0); Oa1 = MFMA32(v1, pa[kk], Oa1); Oc0 = MFMA32(v0, pc[kk], Oc0); Oc1 = MFMA32(v1, pc[kk], Oc1); }
        if (it + 1 < n_tiles) A6_STORE((it + 1) & 1);
        __syncthreads();
    }
#undef A6_LOAD
#undef A6_STORE
    const float inva = 1.f / xhalf_sum(lsa), invc = 1.f / xhalf_sum(lsc);
    bf16_t* ya = Yb + (size_t)(64 * wave + r) * D; bf16_t* yc = ya + (size_t)32 * D;
#pragma unroll
    for (int q = 0; q < 4; ++q) { u32x2 o;
        o.x = pg8::cvt_pk_bf16(Oa0[4 * q] * inva, Oa0[4 * q + 1] * inva); o.y = pg8::cvt_pk_bf16(Oa0[4 * q + 2] * inva, Oa0[4 * q + 3] * inva); *(u32x2*)(ya + 8 * q + 4 * h) = o;
        o.x = pg8::cvt_pk_bf16(Oa1[4 * q] * inva, Oa1[4 * q + 1] * inva); o.y = pg8::cvt_pk_bf16(Oa1[4 * q + 2] * inva, Oa1[4 * q + 3] * inva); *(u32x2*)(ya + 32 + 8 * q + 4 * h) = o;
        o.x = pg8::cvt_pk_bf16(Oc0[4 * q] * invc, Oc0[4 * q + 1] * invc); o.y = pg8::cvt_pk_bf16(Oc0[4 * q + 2] * invc, Oc0[4 * q + 3] * invc); *(u32x2*)(yc + 8 * q + 4 * h) = o;
        o.x = pg8::cvt_pk_bf16(Oc1[4 * q] * invc, Oc1[4 * q + 1] * invc); o.y = pg8::cvt_pk_bf16(Oc1[4 * q + 2] * invc, Oc1[4 * q + 3] * invc); *(u32x2*)(yc + 32 + 8 * q + 4 * h) = o; }
}

#define XB_TMO      128
#define XB_XCNT(j)  (256  + 64 * (j))
#define XB_XSUB(j)  (1280 + 64 * (j))
#define XB_XGEN(j)  (2304 + 64 * (j))
#define XB_TOP      3328
#define XB_TOPGEN   3392
#define XCD_BAR_WORDS 3456
#define XB_SPIN_CAP (1u << 18)

__device__ __forceinline__ unsigned xb_ld(unsigned* p)              { return __hip_atomic_load(p, __ATOMIC_RELAXED, __HIP_MEMORY_SCOPE_AGENT); }
__device__ __forceinline__ unsigned xb_add(unsigned* p, unsigned v) { return __hip_atomic_fetch_add(p, v, __ATOMIC_RELAXED, __HIP_MEMORY_SCOPE_AGENT); }
__device__ __forceinline__ unsigned xb_xcc_id() { return (unsigned)__builtin_amdgcn_s_getreg((3 << 11) | 20) & 0xFu; }
#define XB_SPIN(cond, bar) do { unsigned _sp = 0; while (cond) { __builtin_amdgcn_s_sleep(1); \
    if ((++_sp & 255u) == 0u) { if (xb_ld(&(bar)[XB_TMO])) break; if (_sp > XB_SPIN_CAP) { atomicAdd(&(bar)[XB_TMO], 1u); break; } } } } while (0)

struct XcdBarrier {
    unsigned* bar; unsigned x;
    volatile LAS unsigned* st;
};

__device__ __forceinline__ XcdBarrier xcd_barrier_post(unsigned* bar, volatile LAS unsigned* st, int tid) {
    XcdBarrier b; b.bar = bar; b.x = xb_xcc_id(); b.st = st;
    if (tid == 0) (void)xb_add(&bar[XB_XCNT(b.x)], 1u);
    return b;
}
__device__ __forceinline__ void xcd_barrier_complete(unsigned* bar, unsigned x, unsigned& nloc, unsigned& nx) {
    const unsigned G = gridDim.x * gridDim.y * gridDim.z;
    unsigned sum, cnt, mine, sp = 0u;
    for (;;) {
        sum = 0u; cnt = 0u; mine = 0u;
#pragma unroll
        for (unsigned j = 0; j < 16; ++j) { const unsigned c = xb_ld(&bar[XB_XCNT(j)]); sum += c; cnt += (c > 0u) ? 1u : 0u; mine = (j == x) ? c : mine; }
        if (sum == G) break;
        __builtin_amdgcn_s_sleep(1);
        if ((++sp & 255u) == 0u) { if (xb_ld(&bar[XB_TMO])) break; if (sp > XB_SPIN_CAP) { atomicAdd(&bar[XB_TMO], 1u); break; } }
    }
    nloc = mine > 0u ? mine : 1u; nx = cnt > 0u ? cnt : 1u;
}

__device__ __forceinline__ void xcd_barrier(const XcdBarrier& b, int tid) {
    asm volatile("s_waitcnt vmcnt(0)" ::: "memory");
    __syncthreads();
    if (tid == 0) {
        unsigned* bar = b.bar;
        __builtin_amdgcn_s_waitcnt(0);
        unsigned nloc = b.st[0], nx = b.st[1];
        if (nloc == 0u) { xcd_barrier_complete(bar, b.x, nloc, nx); b.st[0] = nloc; b.st[1] = nx; }
        const unsigned old = xb_add(&bar[XB_XSUB(b.x)], 1u);
        const unsigned gen = old / nloc;
        if (old + 1u == (gen + 1u) * nloc) {
            __builtin_amdgcn_fence(__ATOMIC_RELEASE, "agent");
            asm volatile("s_waitcnt vmcnt(0)" ::: "memory");
            const unsigned og = xb_add(&bar[XB_TOP], 1u);
            const unsigned tg = og / nx;
            if (og + 1u == (tg + 1u) * nx) xb_add(&bar[XB_TOPGEN], 1u);
            else XB_SPIN(xb_ld(&bar[XB_TOPGEN]) == tg, bar);
            __builtin_amdgcn_fence(__ATOMIC_ACQUIRE, "agent");
            xb_add(&bar[XB_XGEN(b.x)], 1u);
            asm volatile("s_waitcnt vmcnt(0)" ::: "memory");
        } else {
            XB_SPIN(xb_ld(&bar[XB_XGEN(b.x)]) == gen, bar);
            __builtin_amdgcn_fence(__ATOMIC_ACQUIRE, "agent");
            asm volatile("s_waitcnt vmcnt(0)" ::: "memory");
        }
    }
    __syncthreads();
}

__global__ void __launch_bounds__(NTHR) fwd_megakernel(Args a_unused) {
    extern __shared__ __attribute__((aligned(16))) unsigned char lds_raw[];
    cg::grid_group grid = cg::this_grid();
    const int ph_lo = a_unused.ph_lo, ph_hi = a_unused.ph_hi;
    const int wave0 = __builtin_amdgcn_readfirstlane((int)(threadIdx.x >> 6));
    XcdBarrier xbar;
    { volatile LAS unsigned* st = (volatile LAS unsigned*)((LAS unsigned char*)lds_raw + LDS_BYTES - 64);
      if (threadIdx.x < 2) st[threadIdx.x] = 0u;
      __syncthreads();
      xbar = xcd_barrier_post((unsigned*)(a_unused.ws + OFF_BAR), st, (int)threadIdx.x); }
    int rep = 0; (void)rep;
    for (int ph = ph_lo; ph < ph_hi; ++ph) {
        ArgP a = (ArgP)__builtin_amdgcn_kernarg_segment_ptr();
        asm volatile("" : "+s"(a));
        LAS unsigned char* lds = (LAS unsigned char*)lds_raw;
        int bid = blockIdx.x, G = gridDim.x, wave = wave0;
        asm volatile("" : "+s"(bid)); asm volatile("" : "+s"(G)); asm volatile("" : "+s"(wave));
        const int gw = bid * NWAVES + wave, NGW = G * NWAVES;
#define GETLANE() int lane; asm volatile("v_mbcnt_lo_u32_b32 %0, -1, 0\n\tv_mbcnt_hi_u32_b32 %0, -1, %0" : "=v"(lane)); const int tid = wave * 64 + lane
#if defined(PROBE_PARTS)
        const int pm = rep ? PROBE_PARTS : 7;
#else
        const int pm = 7;
#endif
        unsigned char* ws = a->ws;
        float* hl = a->out; float* hc = (float*)(ws + OFF_HC);
        bf16_t* XN = (bf16_t*)(ws + OFF_XN);
        unsigned char* wb = ws + OFF_W;
        if (ph == 0) { GETLANE(); p0_phase(a, lds, tid, wave, lane, bid, G); }
        else {
            const int l = (ph - 1) / 13, j = (ph - 1) % 13;
            const float* modl = (const float*)(ws + OFF_MOD) + (size_t)l * 5 * 9216;
            const int nctx = (l == DEPTH - 1 && j >= 9) ? 0 : 4;
            if (j == 0) { GETLANE(); (void)tid; convert_weights(a, l, lds, gw, NGW, wave, lane); norm_phase(hl, hc, a->in[6] + l * D, modl, 0, XN, gw, NGW, lane, MTOT, (const float*)(ws + OFF_PART), l > 0 ? 11 : 0); }
            else if (j == 3) { GETLANE(); (void)tid; norm_phase(hl, hc, a->in[9] + l * D, modl, 3, XN, gw, NGW, lane, MTOT, (const float*)(ws + OFF_PART), 11); }
            else if (j == 10) { GETLANE(); (void)tid; norm_phase(hl, hc, a->in[28] + l * D, modl, 6, XN, gw, NGW, lane, nctx ? MTOT : MLAT, (const float*)(ws + OFF_PART), nctx ? 4 : 0); }
            else if (j == 1 || j == 11) {
                GETLANE(); (void)lane;
                pg8::Gemm g{XN, (const bf16_t*)(wb + (j == 1 ? W_FFN1_IN : W_FFN2_IN)), MTOT, 2 * DFF, D}; CtxOrder S; S.init(2 * DFF, D, G, bid, nctx, 1);
                EpiSwiGLU E{(bf16_t*)(ws + OFF_HFF)}; pg8::gemm_phase<EpiSwiGLU, CtxOrder, true, true>(lds, g, S, E, tid); }
            else if (j == 2 || j == 9 || j == 12) {
                GETLANE(); (void)lane;
                const bf16_t* A = j == 9 ? XN : (const bf16_t*)(ws + OFF_HFF);
                const bf16_t* Bt = (const bf16_t*)(wb + (j == 2 ? W_FFN1_OUT : (j == 9 ? W_OUT : W_FFN2_OUT)));
                const int Kd = j == 9 ? D : DFF;
                pg8::Gemm g{A, Bt, MTOT, D, Kd}; CtxOrder S; S.init(D, Kd, G, bid, nctx, j == 9 ? 4 : 11, j == 9 ? 0 : 1);
                EpiResid E{hl, hc, modl + (j == 2 ? 2 : (j == 9 ? 5 : 8)) * 1024, j == 9 ? 1.0f : 0.5f}; pg8::gemm_phase<EpiResid, CtxOrder, true, true>(lds, g, S, E, tid); }
            else if (j == 4 || j == 6) {
                const int ng = j == 4 ? 1 : 2;
                for (int q = 0; q < ng; ++q) {
                    GETLANE(); (void)lane;
                    const bf16_t* A; const bf16_t* Bt; bf16_t* O; int N, K, ldc;
                    if (j == 4) { A = XN; Bt = (const bf16_t*)(wb + W_IN); O = (bf16_t*)(ws + OFF_Z); N = 2048; K = D; ldc = INW; }
                    else if (q == 0) { A = (const bf16_t*)(ws + OFF_CQN); Bt = (const bf16_t*)(wb + W_UQ); O = (bf16_t*)(ws + OFF_QRAW); N = 768; K = 256; ldc = 576; }
                    else { A = (const bf16_t*)(ws + OFF_CKVN); Bt = (const bf16_t*)(wb + W_UKV); O = (bf16_t*)(ws + OFF_KVRAW); N = 768; K = 256; ldc = 768; }
                    pg8::Gemm g{A, Bt, MTOT, N, K}; CtxOrder S; S.init(N, K, G, bid, 4, 1);
                    EpiStore E{O, ldc, ldc}; pg8::gemm_phase<EpiStore, CtxOrder, true, true>(lds, g, S, E, tid);
                } }
            else if (j == 5) { GETLANE(); if (pm & 1) mixprep_rows(a, l, gw, NGW, lane);
                if (pm & 4) for (int tl = bid; tl < 528; tl += G) mixprep_tile(a, l, tl, lds, tid, wave, lane, pm);
                if (pm & 2) lru_wave_phase<false>(a, l, lds, gw, NGW, wave, lane, tid); }
            else if (j == 7) {
                GETLANE();
                if (pm & 1) mlapost_rows(a, l, gw, NGW, lane);
                if (pm & 2) for (int tl = bid; tl < 528; tl += G) mlapost_tile(a, l, tl, lds, tid, wave, lane, pm);
                if ((pm & 4) && wave == 0) { for (int item = G - 1 - bid; item < 48; item += G) lru_carry(a, item, lane); } }
            else if (j == 8) {
                bf16_t* Y = XN;
                const int vb = (G & 7) == 0 ? (bid & 7) * (G >> 3) + (bid >> 3) : bid;
                if (pm & 1) { GETLANE(); (void)lane;
                    for (int u = vb; u < 256; u += G) {
                        int bh, idx; if (u < 176) { bh = u / 11; idx = u % 11; } else { const int v = u - 176; bh = 16 + v / 10; idx = v % 10; }
                        const int b = bh / 6, hh = bh % 6;
                        bf16_t* Yb = Y + (size_t)(b * T + 512 * idx) * D + 384 + hh * 64;
                        attn_unit_mla64(lds, (const bf16_t*)(ws + OFF_QM) + (size_t)bh * P * 96, (const bf16_t*)(ws + OFF_KM) + (size_t)bh * P * 96, (const bf16_t*)(ws + OFF_VMT) + (size_t)bh * 64 * P, Yb, idx, tid); }
                    for (int u = vb; u < 256; u += G) {
                        int bh, qs; if (u < 160) { bh = u / 10; qs = 5632 + 256 * (u % 10); } else { const int v = u - 160; bh = 16 + v / 12; qs = 5120 + 256 * (v % 12); }
                        const int b = bh / 6, hh = bh % 6;
                        bf16_t* Yb = Y + (size_t)(b * T + qs) * D + 384 + hh * 64;
                        attn_unit<96, false>(lds, (const bf16_t*)(ws + OFF_QM) + (size_t)bh * P * 96, (const bf16_t*)(ws + OFF_KM) + (size_t)bh * P * 96, (const bf16_t*)(ws + OFF_VMT) + (size_t)bh * 64 * P, Yb, 1 + qs / 256, nullptr, tid); }
                    for (int u = vb; u < 24; u += G) {
                        const int b = u / 6, hh = u % 6; const size_t bh = (size_t)(b * 6 + hh);
                        bf16_t* Yb = Y + (size_t)(MLAT + b * C) * D + 384 + hh * 64;
                        attn_unit<96, false>(lds, (const bf16_t*)(ws + OFF_QM) + bh * P * 96, (const bf16_t*)(ws + OFF_KM) + bh * P * 96, (const bf16_t*)(ws + OFF_VMT) + bh * 64 * P, Yb, 0, nullptr, tid); }
                }
                { GETLANE(); (void)lane;
                LAS float* rpbl = (LAS float*)(lds + 49152);
                for (int i = tid; i < 4 * 465; i += NTHR) rpbl[i] = a->in[27][l * 4 * 465 + i] * LOG2E;
                __syncthreads();
                if (pm & 2) for (int u = vb; u < 528; u += G) {
                    int b, hh, qb; if (u < 512) { b = u / 128; hh = (u % 128) / 32; qb = 1 + (u & 31); } else { const int v = u - 512; b = v / 4; hh = v % 4; qb = 0; }
                    const size_t bh = (size_t)(b * 4 + hh);
                    bf16_t* Yb = Y + (size_t)(qb == 0 ? MLAT + b * C : b * T + 256 * (qb - 1)) * D + 768 + hh * 64;
                    attn_unit<64, true>(lds, (const bf16_t*)(ws + OFF_NQ) + bh * P * 64, (const bf16_t*)(ws + OFF_NK) + bh * P * 64, (const bf16_t*)(ws + OFF_NVT) + bh * 64 * P, Yb, qb, rpbl + hh * 465, tid);
                } }
                if (pm & 4) { GETLANE(); lru_wave_phase<true>(a, l, lds, gw, NGW, wave, lane, tid); }
            }
        }
#if defined(PROBE_SYNC2)
        if (ph + 1 < ph_hi) { GETLANE(); xcd_barrier(xbar, tid); }
#endif
#if defined(PROBE_REPEAT)
        if (ph > 0 && ((ph - 1) % 13) == PROBE_REPEAT && !rep) { rep = 1; --ph; } else rep = 0;
#endif
        if (ph + 1 < ph_hi) { if (ph == 0) grid.sync(); else { int l2; asm volatile("v_mbcnt_lo_u32_b32 %0, -1, 0\n\tv_mbcnt_hi_u32_b32 %0, -1, %0" : "=v"(l2)); xcd_barrier(xbar, wave0 * 64 + l2); } }
    }
}

extern "C" void kernel_launch(void* const* d_in, const int* in_sizes, int n_in, void* d_out, int out_size, void* d_ws, size_t ws_size, hipStream_t stream) {
    static int grid = 0;
    if (grid == 0) {
        if (n_in != 31 || out_size != MLAT * D || ws_size < WS_END2) { fprintf(stderr, "kernel_launch: unexpected problem (n_in %d, out %d, ws %zu < %zu)\n", n_in, out_size, ws_size, (size_t)WS_END2); grid = -1; return; }
        int dev = 0, cus = 0, per_cu = 0;
        hipGetDevice(&dev); hipDeviceGetAttribute(&cus, hipDeviceAttributeMultiprocessorCount, dev);
        if (hipFuncSetAttribute((const void*)fwd_megakernel, hipFuncAttributeMaxDynamicSharedMemorySize, LDS_BYTES) != hipSuccess) { fprintf(stderr, "kernel_launch: hipFuncSetAttribute failed\n"); grid = -1; return; }
        if (hipOccupancyMaxActiveBlocksPerMultiprocessor(&per_cu, (const void*)fwd_megakernel, NTHR, LDS_BYTES) != hipSuccess || per_cu < 1) { fprintf(stderr, "kernel_launch: occupancy query says %d\n", per_cu); per_cu = 1; }
        (void)hipGetLastError();
        grid = cus;
    }
    if (grid < 0) return;
    if (hipMemsetAsync((char*)d_ws + OFF_BAR, 0, XCD_BAR_WORDS * 4, stream) != hipSuccess) { fprintf(stderr, "kernel_launch: memset of the barrier words failed\n"); return; }
    Args a{};
    for (int i = 0; i < 31; ++i) a.in[i] = (const float*)d_in[i];
    a.out = (float*)d_out; a.ws = (unsigned char*)d_ws; a.ph_lo = 0; a.ph_hi = 1 + 13 * DEPTH;
    void* args[] = {&a};
    hipError_t e = hipLaunchCooperativeKernel((const void*)fwd_megakernel, dim3(grid), dim3(NTHR), args, LDS_BYTES, stream);
    if (e != hipSuccess) fprintf(stderr, "kernel_launch: cooperative launch failed: %s (grid %d)\n", hipGetErrorString(e), grid);
}
```

```cpp
#include <hip/hip_runtime.h>
#include <hip/hip_cooperative_groups.h>
#include <cstdio>
#include <cstdint>
namespace cg = cooperative_groups;
namespace pg8 {
#define PG8_LAS __attribute__((address_space(3)))
typedef unsigned short bf16_t;
typedef short bf16x8 __attribute__((ext_vector_type(8)));
typedef float f32x4 __attribute__((ext_vector_type(4)));
typedef unsigned u32x4 __attribute__((ext_vector_type(4)));
constexpr int BM = 256, BK = 64, HALF = 128, HTB = HALF * BK * 2  , STAGE_BYTES = 8 * HTB, NXCD = 8, WGM = 8;

__host__ __device__ __forceinline__ int lds_byte(int r, int c) { const int st = (r >> 4) * 2 + (c >> 5), rr = r & 15, cc = c & 31, ob = rr * 64 + cc * 2; return st * 1024 + (ob ^ (((ob >> 9) & 1) << 5)); }
__host__ __device__ __forceinline__ void stage_rc(int b, int& R, int& C) { const int st = b / 1024, sb = b % 1024, swz = sb ^ (((sb >> 9) & 1) << 5); R = (st >> 1) * 16 + swz / 64; C = (st & 1) * 32 + (swz % 64) / 2; }
__host__ __device__ __forceinline__ int perm32(int rho) { const int n = rho >> 4, i = rho & 15; return 8 * (i >> 2) + 4 * n + (i & 3); }

struct Unit { int pm, pn; };
struct Gemm { const bf16_t* A; const bf16_t* Bt; int M, N, K; };

struct StaticOrder {
    int nM, nN, nwg, G, c;
    __host__ __device__ void init(int M, int N, int G_, int c_) { nM = M / BM; nN = N / BM; nwg = nM * nN; G = G_; c = c_; }
    __host__ __device__ bool next(int i, Unit& u) const {
        const long L = (long)i * G + c; if (L >= nwg) return false;
        int wgid = (int)L; { const int q = nwg / NXCD, r = nwg % NXCD, xcd = wgid % NXCD, off = wgid / NXCD; wgid = (xcd < r ? xcd * (q + 1) : r * (q + 1) + (xcd - r) * q) + off; }
        const int nig = WGM * nN, gid = wgid / nig, fm = gid * WGM, gsz = (nM - fm) < WGM ? (nM - fm) : WGM;
        u.pm = fm + ((wgid % nig) % gsz); u.pn = (wgid % nig) / gsz; return true;
    }
    __device__ __forceinline__ void a_ready(const Unit&) const {}
    __device__ __forceinline__ void done(const Unit&) const {}
};

typedef _Float16 f16x8 __attribute__((ext_vector_type(8)));
typedef _Float16 f16x2 __attribute__((ext_vector_type(2)));
__device__ __forceinline__ unsigned cvt_pk_bf16(float lo, float hi) { f16x2 v; v.x = (_Float16)lo; v.y = (_Float16)hi; return __builtin_bit_cast(unsigned, v); }

template <class Epi, class Sched, bool ALIGN_EPI = false, bool SP2 = false>
__device__ __forceinline__ void gemm_phase(PG8_LAS unsigned char* lds, const Gemm g, const Sched& S, const Epi& E, const int tid_in) {
    const int tid = tid_in;
    const int wid = __builtin_amdgcn_readfirstlane(tid >> 6), lane = tid & 63, wr = wid >> 2, wc = wid & 3, fr = lane & 15, fq = lane >> 4;
    const int K = g.K;
    unsigned voffA[2], voffB[2];
#pragma unroll
    for (int i = 0; i < 2; ++i) { int R, C; stage_rc(tid * 16 + i * 8192, R, C); const int Rb = Epi::PERM ? ((R & ~31) + perm32(R & 31)) : R;
        voffA[i] = (unsigned)(R * K + C) * 2u; voffB[i] = (unsigned)(Rb * K + C) * 2u; }
    const size_t kstep = (size_t)(BK * 2);
    const size_t hstep = (size_t)HALF * K * 2;
    const size_t tstep = 2 * hstep;
    const unsigned ldsw = (unsigned)wid * 1024u;
    const int aoff = lds_byte(wr * 64 + fr, fq * 8), boff = lds_byte(wc * 32 + fr, fq * 8);
#define PG8_SA(b, h) (((b) * 2 + (h)) * HTB)
#define PG8_SB(b, h) ((4 + (b) * 2 + (h)) * HTB)
#define PG8_STAGE(bufoff, gbase, voff) do { _Pragma("unroll") for (int _i = 0; _i < 2; ++_i) \
        __builtin_amdgcn_global_load_lds((const unsigned*)((const char*)(gbase) + (voff)[_i]), (PG8_LAS unsigned*)(lds + (bufoff) + ldsw + _i * 8192), 16, 0, 0); } while (0)
#define PG8_LDA(dst, b, h) do { _Pragma("unroll") for (int m = 0; m < 4; ++m) _Pragma("unroll") for (int k = 0; k < 2; ++k) dst[m][k] = *(const PG8_LAS bf16x8*)(lds + PG8_SA(b, h) + aoff + m * 2048 + k * 1024); } while (0)
#define PG8_LDB(dst, b, h) do { _Pragma("unroll") for (int n = 0; n < 2; ++n) _Pragma("unroll") for (int k = 0; k < 2; ++k) dst[n][k] = *(const PG8_LAS bf16x8*)(lds + PG8_SB(b, h) + boff + n * 2048 + k * 1024); } while (0)
#define PG8_MMA(ai, bj, At, Bt) do { __builtin_amdgcn_s_setprio(1); _Pragma("unroll") for (int m = 0; m < 4; ++m) _Pragma("unroll") for (int n = 0; n < 2; ++n) _Pragma("unroll") for (int k = 0; k < 2; ++k) \
        acc[ai][bj][m][n] = __builtin_amdgcn_mfma_f32_16x16x32_f16(__builtin_bit_cast(f16x8, Bt[n][k]), __builtin_bit_cast(f16x8, At[m][k]), acc[ai][bj][m][n], 0, 0, 0); __builtin_amdgcn_s_setprio(0); } while (0)
#define PG8_WAIT_V(n) asm volatile("s_waitcnt vmcnt(" #n ")" ::: "memory")
#define PG8_WAIT_L(n) asm volatile("s_waitcnt lgkmcnt(" #n ")" ::: "memory")
#define PG8_BAR __builtin_amdgcn_s_barrier()
#define PG8_SCHED __builtin_amdgcn_sched_barrier(0)
    Unit cur, nxt; int ui = 0;
    if (!S.next(0, cur)) return;
    f32x4 acc[2][2][4][2];
#pragma unroll
    for (int a = 0; a < 2; ++a)
#pragma unroll
        for (int b = 0; b < 2; ++b)
#pragma unroll
            for (int m = 0; m < 4; ++m)
#pragma unroll
                for (int n = 0; n < 2; ++n) acc[a][b][m][n] = (f32x4){0.f, 0.f, 0.f, 0.f};
    bf16x8 At[4][2], B0[2][2], B1[2][2];
#define PG8_PM(u) ((u).pm & 0xffff)
#define PG8_PN(u) ((u).pn & 0xffff)
#define PG8_NT(u) ((u).pm >> 16)
#define PG8_KB(u) ((size_t)((((u).pn >> 16) & 0xff) * ((u).pm >> 16)) * (BK * 2))
    const char* cA = (const char*)g.A + (size_t)PG8_PM(cur) * tstep + PG8_KB(cur); const char* cB = (const char*)g.Bt + (size_t)PG8_PN(cur) * tstep + PG8_KB(cur);
    S.a_ready(cur);
    if constexpr (SP2) {
        PG8_STAGE(PG8_SB(0, 0), cB, voffB); PG8_STAGE(PG8_SB(0, 1), cB + hstep, voffB); PG8_STAGE(PG8_SA(0, 0), cA, voffA); PG8_STAGE(PG8_SA(0, 1), cA + hstep, voffA);
        if (wr == 1) PG8_BAR;
        PG8_WAIT_V(2); PG8_BAR;
        PG8_STAGE(PG8_SB(1, 0), cB + kstep, voffB); PG8_STAGE(PG8_SA(1, 0), cA + kstep, voffA); PG8_STAGE(PG8_SB(1, 1), cB + hstep + kstep, voffB);
        PG8_WAIT_V(6); PG8_BAR;
    } else {
        PG8_STAGE(PG8_SB(0, 0), cB, voffB); PG8_STAGE(PG8_SA(0, 0), cA, voffA); PG8_STAGE(PG8_SB(0, 1), cB + hstep, voffB); PG8_STAGE(PG8_SA(0, 1), cA + hstep, voffA);
        if (wr == 1) PG8_BAR;
        PG8_WAIT_V(4); PG8_BAR;
        PG8_STAGE(PG8_SB(1, 0), cB + kstep, voffB); PG8_STAGE(PG8_SA(1, 0), cA + kstep, voffA); PG8_STAGE(PG8_SB(1, 1), cB + hstep + kstep, voffB);
        PG8_WAIT_V(6); PG8_BAR;
    }
    for (;;) {
        const bool has_next = S.next(ui + 1, nxt);
        const char* nA = has_next ? (const char*)g.A + (size_t)PG8_PM(nxt) * tstep + PG8_KB(nxt) : cA; const char* nB = has_next ? (const char*)g.Bt + (size_t)PG8_PN(nxt) * tstep + PG8_KB(nxt) : cB;
        const int nt = PG8_NT(cur);
        for (int t = 0; t < nt; t += 2) {
            const bool last = (t == nt - 2);
            const char* a1 = cA + (size_t)(t + 1) * kstep;
            const char* a2 = last ? nA : cA + (size_t)(t + 2) * kstep; const char* b2 = last ? nB : cB + (size_t)(t + 2) * kstep;
            const char* a3 = a2 + kstep; const char* b3 = b2 + kstep;
            if (last && has_next) S.a_ready(nxt);
            if constexpr (SP2) {
            PG8_LDB(B0, 0, 0); PG8_LDB(B1, 0, 1); PG8_SCHED; PG8_LDA(At, 0, 0); PG8_STAGE(PG8_SA(1, 1), a1 + hstep, voffA);
            PG8_WAIT_V(8); PG8_WAIT_L(0); PG8_BAR; PG8_MMA(0, 0, At, B0); PG8_MMA(0, 1, At, B1); PG8_BAR; PG8_SCHED;
            PG8_LDA(At, 0, 1); PG8_STAGE(PG8_SB(0, 0), b2, voffB); PG8_STAGE(PG8_SB(0, 1), b2 + hstep, voffB); PG8_STAGE(PG8_SA(0, 0), a2, voffA);
            PG8_WAIT_V(8); PG8_WAIT_L(0); PG8_BAR; PG8_MMA(1, 0, At, B0); PG8_MMA(1, 1, At, B1); PG8_BAR; PG8_SCHED;
            PG8_LDB(B0, 1, 0); PG8_LDB(B1, 1, 1); PG8_SCHED; PG8_LDA(At, 1, 0); PG8_STAGE(PG8_SA(0, 1), a2 + hstep, voffA);
            PG8_WAIT_V(8); PG8_WAIT_L(0); PG8_BAR; PG8_MMA(0, 0, At, B0); PG8_MMA(0, 1, At, B1); PG8_BAR; PG8_SCHED;
            PG8_LDA(At, 1, 1); PG8_STAGE(PG8_SB(1, 0), b3, voffB); PG8_STAGE(PG8_SB(1, 1), b3 + hstep, voffB); PG8_STAGE(PG8_SA(1, 0), a3, voffA);
            PG8_WAIT_V(8); PG8_WAIT_L(0); PG8_BAR; PG8_MMA(1, 0, At, B0); PG8_MMA(1, 1, At, B1); PG8_BAR; PG8_SCHED;
            } else {
            PG8_LDB(B0, 0, 0); PG8_SCHED; PG8_LDA(At, 0, 0); PG8_STAGE(PG8_SA(1, 1), a1 + hstep, voffA);
            PG8_WAIT_L(8); PG8_BAR; PG8_WAIT_L(0); PG8_MMA(0, 0, At, B0); PG8_BAR; PG8_SCHED;
            PG8_LDB(B1, 0, 1); PG8_STAGE(PG8_SB(0, 0), b2, voffB);
            PG8_BAR; PG8_WAIT_L(0); PG8_MMA(0, 1, At, B1); PG8_BAR;
            PG8_LDA(At, 0, 1); PG8_STAGE(PG8_SA(0, 0), a2, voffA);
            PG8_BAR; PG8_WAIT_L(0); PG8_MMA(1, 0, At, B0); PG8_BAR; PG8_SCHED;
            PG8_STAGE(PG8_SB(0, 1), b2 + hstep, voffB);
            PG8_WAIT_V(6); PG8_BAR; PG8_MMA(1, 1, At, B1); PG8_BAR;
            PG8_LDB(B0, 1, 0); PG8_SCHED; PG8_LDA(At, 1, 0); PG8_STAGE(PG8_SA(0, 1), a2 + hstep, voffA);
            PG8_WAIT_L(8); PG8_BAR; PG8_WAIT_L(0); PG8_MMA(0, 0, At, B0); PG8_BAR; PG8_SCHED;
            PG8_LDB(B1, 1, 1); PG8_STAGE(PG8_SB(1, 0), b3, voffB);
            PG8_BAR; PG8_WAIT_L(0); PG8_MMA(0, 1, At, B1); PG8_BAR;
            PG8_LDA(At, 1, 1); PG8_STAGE(PG8_SA(1, 0), a3, voffA);
            PG8_BAR; PG8_WAIT_L(0); PG8_MMA(1, 0, At, B0); PG8_BAR; PG8_SCHED;
            PG8_STAGE(PG8_SB(1, 1), b3 + hstep, voffB);
            PG8_WAIT_V(6); PG8_BAR; PG8_MMA(1, 1, At, B1); PG8_BAR;
            }
        }
        if constexpr (ALIGN_EPI) { if (wr == 0) PG8_BAR; }
        if constexpr (!Epi::AFTER_DRAIN) { E(acc, cur, wr, wc, fr, fq); S.done(cur); }
        if (!has_next) break;
#pragma unroll
        for (int a = 0; a < 2; ++a)
#pragma unroll
            for (int b = 0; b < 2; ++b)
#pragma unroll
                for (int m = 0; m < 4; ++m)
#pragma unroll
                    for (int n = 0; n < 2; ++n) acc[a][b][m][n] = (f32x4){0.f, 0.f, 0.f, 0.f};
        cur = nxt; cA = nA; cB = nB; ++ui;
        if constexpr (ALIGN_EPI) { if (wr == 1) PG8_BAR; }
    }
    PG8_WAIT_V(0);
    if constexpr (!ALIGN_EPI) { if (wr == 0) PG8_BAR; }
    PG8_BAR;
    if constexpr (Epi::AFTER_DRAIN) { E.fused(acc, cur, wr, wc, fr, fq, lds, wid, lane); S.done(cur); }
#undef PG8_SA
#undef PG8_SB
#undef PG8_STAGE
#undef PG8_LDA
#undef PG8_LDB
#undef PG8_MMA
#undef PG8_WAIT_V
#undef PG8_WAIT_L
#undef PG8_BAR
#undef PG8_SCHED
}
}

#define LAS __attribute__((address_space(3)))
typedef unsigned short bf16_t;
typedef short bf16x8 __attribute__((ext_vector_type(8)));
typedef float f32x4 __attribute__((ext_vector_type(4)));
typedef float f32x16 __attribute__((ext_vector_type(16)));
typedef unsigned u32x4 __attribute__((ext_vector_type(4)));
typedef unsigned u32x2 __attribute__((ext_vector_type(2)));

constexpr int NB = 4, T = 8192, C = 256, P = T + C, D = 1024, DFF = 2816, INW = 1952, DEPTH = 4;
constexpr int MLAT = NB * T, MTOT = MLAT + NB * C;
constexpr int NWAVES = 8, NTHR = 512;
constexpr float EPS = 1e-6f, LOG2E = 1.4426950408889634f;
constexpr int NCHUNK = P / 32;
constexpr int Z_LX = 0, Z_LG = 384, Z_CQ = 768, Z_CKV = 1024, Z_KR = 1152, Z_NQ = 1184, Z_NK = 1440, Z_NV = 1696;

constexpr size_t MiB = 1u << 20;
constexpr size_t OFF_MOD = 0;
constexpr size_t OFF_ROPE = 1 * MiB;
constexpr size_t OFF_BAR = 1 * MiB + 65536;
constexpr size_t OFF_LRUS = 2 * MiB;
constexpr size_t OFF_LRUC = 9 * MiB;
constexpr size_t OFF_HC = 13 * MiB;
constexpr size_t OFF_W = 18 * MiB;
constexpr size_t W_FFN1_IN = 0, W_FFN1_OUT = W_FFN1_IN + (size_t)5632 * 1024 * 2, W_FFN2_IN = W_FFN1_OUT + (size_t)1024 * 2816 * 2,
                 W_FFN2_OUT = W_FFN2_IN + (size_t)5632 * 1024 * 2, W_IN = W_FFN2_OUT + (size_t)1024 * 2816 * 2, W_OUT = W_IN + (size_t)2048 * 1024 * 2,
                 W_UQ = W_OUT + (size_t)1024 * 1024 * 2, W_UKV = W_UQ + (size_t)768 * 256 * 2, W_LRU = W_UKV + (size_t)768 * 256 * 2, W_END = W_LRU + (size_t)24 * 64 * 64 * 2;
static_assert(W_END <= 42 * MiB, "weights");
constexpr size_t OFF_XN = 60 * MiB;
constexpr size_t OFF_BIG = 126 * MiB;
constexpr size_t OFF_HFF = OFF_BIG;
constexpr size_t OFF_Z = OFF_BIG;
constexpr size_t OFF_CQN = OFF_Z + (size_t)MTOT * INW * 2;
constexpr size_t OFF_CKVN = OFF_CQN + (size_t)MTOT * 256 * 2;
constexpr size_t OFF_QRAW = OFF_CKVN + (size_t)MTOT * 256 * 2;
constexpr size_t OFF_KVRAW = OFF_QRAW + (size_t)MTOT * 576 * 2;
constexpr size_t OFF_QM = OFF_KVRAW + (size_t)MTOT * 768 * 2;
constexpr size_t OFF_KM = OFF_QM + (size_t)NB * 6 * P * 96 * 2;
constexpr size_t OFF_VMT = OFF_KM + (size_t)NB * 6 * P * 96 * 2;
constexpr size_t OFF_NQ = OFF_VMT + (size_t)NB * 6 * 64 * P * 2;
constexpr size_t OFF_NK = OFF_NQ + (size_t)NB * 4 * P * 64 * 2;
constexpr size_t OFF_NVT = OFF_NK + (size_t)NB * 4 * P * 64 * 2;
constexpr size_t WS_END = OFF_NVT + (size_t)NB * 4 * 64 * P * 2;
constexpr size_t OFF_PART = WS_END;
constexpr size_t WS_END2 = OFF_PART + (size_t)11 * 1024 * 1024 * 4;
static_assert(OFF_XN + (size_t)MTOT * 1024 * 2 <= OFF_BIG && OFF_HFF + (size_t)MTOT * DFF * 2 <= WS_END, "ws map");

constexpr int LDS_BYTES = 147456;

using pg8::f16x8; using pg8::f16x2;
__device__ __forceinline__ unsigned f2bf(float f) { return (unsigned)__builtin_bit_cast(unsigned short, (_Float16)f); }
__device__ __forceinline__ unsigned pk2(float lo, float hi) { return pg8::cvt_pk_bf16(lo, hi); }
__device__ __forceinline__ float bflo(unsigned u) { return (float)__builtin_bit_cast(f16x2, u).x; }
__device__ __forceinline__ float bfhi(unsigned u) { return (float)__builtin_bit_cast(f16x2, u).y; }
__device__ __forceinline__ float bf2f(bf16_t x) { return (float)__builtin_bit_cast(_Float16, x); }
#define MFMA32(a, b, c) __builtin_amdgcn_mfma_f32_32x32x16_f16(__builtin_bit_cast(f16x8, (a)), __builtin_bit_cast(f16x8, (b)), (c), 0, 0, 0)
template <int O> __device__ __forceinline__ float swz_xor(float x) { return __builtin_bit_cast(float, __builtin_amdgcn_ds_swizzle(__builtin_bit_cast(int, x), (O << 10) | 0x1f)); }
__device__ __forceinline__ float xhalf(float x) {
    const unsigned xb = __builtin_bit_cast(unsigned, x); auto t = __builtin_amdgcn_permlane32_swap(xb, xb, false, false);
    return __builtin_bit_cast(float, t[0] == xb ? t[1] : t[0]); }
__device__ __forceinline__ float xhalf_sum(float x) { const unsigned xb = __builtin_bit_cast(unsigned, x); auto t = __builtin_amdgcn_permlane32_swap(xb, xb, false, false);
    return __builtin_bit_cast(float, (unsigned)t[0]) + __builtin_bit_cast(float, (unsigned)t[1]); }
__device__ __forceinline__ float xhalf_max(float x) { const unsigned xb = __builtin_bit_cast(unsigned, x); auto t = __builtin_amdgcn_permlane32_swap(xb, xb, false, false);
    return fmaxf(__builtin_bit_cast(float, (unsigned)t[0]), __builtin_bit_cast(float, (unsigned)t[1])); }
template <int CTRL> __device__ __forceinline__ float dppf(float x) { return __builtin_bit_cast(float, __builtin_amdgcn_mov_dpp(__builtin_bit_cast(int, x), CTRL, 0xf, 0xf, true)); }
__device__ __forceinline__ float row16_sum(float v) { v += dppf<0xB1>(v); v += dppf<0x4E>(v); v += dppf<0x141>(v); v += dppf<0x140>(v); return v; }
__device__ __forceinline__ float wave_sum(float v) {
    v = row16_sum(v);
    { const unsigned xb = __builtin_bit_cast(unsigned, v); auto t = __builtin_amdgcn_permlane16_swap(xb, xb, false, false); v = __builtin_bit_cast(float, (unsigned)t[0]) + __builtin_bit_cast(float, (unsigned)t[1]); }
    return xhalf_sum(v);
}
__device__ __forceinline__ float sigmoidf_(float x) { return __builtin_amdgcn_rcpf(1.f + __expf(-x)); }
__device__ __forceinline__ int clampi(int v, int lo, int hi) { return v < lo ? lo : (v > hi ? hi : v); }
#define LDS_WAIT() asm volatile("s_waitcnt lgkmcnt(0)" ::: "memory")

struct EpiStore {
    static constexpr bool PERM = true, AFTER_DRAIN = false;
    bf16_t* O; int ldc; int ncols;
    __device__ __forceinline__ void operator()(const pg8::f32x4 (&acc)[2][2][4][2], const pg8::Unit& uu, int wr, int wc, int fr, int fq) const {
        asm volatile("" : "+v"(fr), "+v"(fq));
        const int upm = uu.pm & 0xffff, upn = uu.pn & 0xffff, unt = uu.pm >> 16; (void)unt;
        const int row0 = upm * 256 + wr * 64 + fr, col0 = upn * 256 + wc * 32 + 8 * fq;
#pragma unroll
        for (int ai = 0; ai < 2; ++ai)
#pragma unroll
            for (int m = 0; m < 4; ++m) { bf16_t* rowp = O + (size_t)(row0 + ai * 128 + m * 16) * ldc;
#pragma unroll
                for (int bj = 0; bj < 2; ++bj) { const int col = col0 + bj * 128;
                    if (col < ncols) { const pg8::f32x4 v0 = acc[ai][bj][m][0], v1 = acc[ai][bj][m][1];
                        u32x4 w; w.x = pg8::cvt_pk_bf16(v0[0], v0[1]); w.y = pg8::cvt_pk_bf16(v0[2], v0[3]); w.z = pg8::cvt_pk_bf16(v1[0], v1[1]); w.w = pg8::cvt_pk_bf16(v1[2], v1[3]);
                        *(u32x4*)(rowp + col) = w; } } }
    }
};
struct EpiSwiGLU {
    static constexpr bool PERM = true, AFTER_DRAIN = false;
    bf16_t* O;
    __device__ __forceinline__ void operator()(const pg8::f32x4 (&acc)[2][2][4][2], const pg8::Unit& uu, int wr, int wc, int fr, int fq) const {
        asm volatile("" : "+v"(fr), "+v"(fq));
        const int upm = uu.pm & 0xffff, upn = uu.pn & 0xffff, unt = uu.pm >> 16; (void)unt;
        const int row0 = upm * 256 + wr * 64 + fr, col = upn * 128 + wc * 32 + 8 * fq;
#pragma unroll
        for (int ai = 0; ai < 2; ++ai)
#pragma unroll
            for (int m = 0; m < 4; ++m) { float o[8];
#pragma unroll
                for (int n = 0; n < 2; ++n)
#pragma unroll
                    for (int e = 0; e < 4; ++e) { const float g = acc[ai][0][m][n][e], up = acc[ai][1][m][n][e]; o[4 * n + e] = g * sigmoidf_(g) * up; }
                u32x4 w; w.x = pg8::cvt_pk_bf16(o[0], o[1]); w.y = pg8::cvt_pk_bf16(o[2], o[3]); w.z = pg8::cvt_pk_bf16(o[4], o[5]); w.w = pg8::cvt_pk_bf16(o[6], o[7]);
                *(u32x4*)(O + (size_t)(row0 + ai * 128 + m * 16) * DFF + col) = w; }
    }
};
struct EpiResid {
    static constexpr bool PERM = true, AFTER_DRAIN = false;
    float* hl; float* hc; const float* gate; float coef;
    __device__ __forceinline__ void operator()(const pg8::f32x4 (&acc)[2][2][4][2], const pg8::Unit& uu, int wr, int wc, int fr, int fq) const {
        asm volatile("" : "+v"(fr), "+v"(fq));
        const int upm = uu.pm & 0xffff, upn = uu.pn & 0xffff, unt = uu.pm >> 16; (void)unt;
        float* base; const float* g;
        if (upm < 128) { base = hl + (size_t)upm * 256 * D; g = gate + (upm >> 5) * 9216; } else { base = hc + (size_t)(upm - 128) * 256 * D; g = gate + 4 * 9216; }
        const int col0 = upn * 256 + wc * 32 + 8 * fq;
        pg8::f32x4 gv[2][2];
#pragma unroll
        for (int bj = 0; bj < 2; ++bj)
#pragma unroll
            for (int n = 0; n < 2; ++n) gv[bj][n] = *(const pg8::f32x4*)(g + col0 + bj * 128 + 4 * n) * coef;
        if (!((uu.pn >> 30) & 1)) {
#pragma unroll
            for (int ai = 0; ai < 2; ++ai)
#pragma unroll
                for (int m = 0; m < 4; ++m) { float* rowp = base + (size_t)(wr * 64 + fr + ai * 128 + m * 16) * D + col0;
#pragma unroll
                    for (int bj = 0; bj < 2; ++bj)
#pragma unroll
                        for (int n = 0; n < 2; ++n) { pg8::f32x4* p = (pg8::f32x4*)(rowp + bj * 128 + 4 * n); *p = *p + gv[bj][n] * acc[ai][bj][m][n]; } }
        } else {
            float* pb = hc + (OFF_PART - OFF_HC) / 4 + ((size_t)((uu.pn >> 16) & 0xff) * 1024 + (size_t)(upm - 128) * 256) * D;
#pragma unroll
            for (int ai = 0; ai < 2; ++ai)
#pragma unroll
                for (int m = 0; m < 4; ++m) { float* rowp = pb + (size_t)(wr * 64 + fr + ai * 128 + m * 16) * D + col0;
#pragma unroll
                    for (int bj = 0; bj < 2; ++bj)
#pragma unroll
                        for (int n = 0; n < 2; ++n) *(pg8::f32x4*)(rowp + bj * 128 + 4 * n) = gv[bj][n] * acc[ai][bj][m][n]; }
        }
    }
};

struct CtxOrder {
    int n_lat, n_ctx, nN, ksplit, ntfull, G, c;
    __device__ __forceinline__ void init(int N, int K, int G_, int c_, int nctx_panels, int ksplit_) { nN = N / 256; n_lat = 128 * nN; ksplit = ksplit_; ntfull = K / 64; n_ctx = nctx_panels * nN * ksplit_; G = G_; c = c_; }
    __device__ __forceinline__ bool next(int i, pg8::Unit& u) const {
        const int L = i * G + c;
        if (L < n_lat) {
            const int wgid = (L & 7) * (n_lat >> 3) + (L >> 3), nig = 8 * nN, w = wgid % nig;
            u.pm = ((wgid / nig) * 8 + (w & 7)) | (ntfull << 16); u.pn = w >> 3; return true; }
        const int q = L - n_lat; if (q >= n_ctx) return false;
        const int ks = q % ksplit, rest = q / ksplit; u.pn = (rest % nN) | (ks << 16) | (ksplit > 1 ? (1 << 30) : 0); u.pm = (128 + rest / nN) | ((ntfull / ksplit) << 16); return true;
    }
    __device__ __forceinline__ void a_ready(const pg8::Unit&) const {}
    __device__ __forceinline__ void done(const pg8::Unit&) const {}
};

template <int MODE> __device__ __forceinline__ int dest_row(int n0) {
    if (MODE == 1) { const int g = n0 >= DFF ? 1 : 0; const int nn = n0 - g * DFF; return (nn >> 7) * 256 + g * 128 + (nn & 127); }
    return n0;
}
template <int MODE> __device__ __forceinline__ void transpose_item(const float* __restrict__ W, int N, bf16_t* __restrict__ WT, int ldk, LAS float* scr, int item, int lane) {
    const int nblk = N / 32, kb = item / nblk, nb = item % nblk, k0 = 64 * kb, n0 = 32 * nb;
#pragma unroll 8
    for (int i = 0; i < 32; ++i) { const int kk = 2 * i + (lane >> 5); scr[kk * 33 + (lane & 31)] = W[(size_t)(k0 + kk) * N + n0 + (lane & 31)]; }
    LDS_WAIT();
    const int c = lane & 7, r0 = dest_row<MODE>(n0);
#pragma unroll
    for (int j = 0; j < 4; ++j) { const int n = (lane >> 3) + 8 * j; const LAS float* s = scr + (8 * c) * 33 + n;
        u32x4 o; o.x = pk2(s[0 * 33], s[1 * 33]); o.y = pk2(s[2 * 33], s[3 * 33]); o.z = pk2(s[4 * 33], s[5 * 33]); o.w = pk2(s[6 * 33], s[7 * 33]);
        *(u32x4*)(WT + (size_t)(r0 + n) * ldk + k0 + 8 * c) = o; }
    LDS_WAIT();
}

struct Args { const float* in[31]; float* out; unsigned char* ws; int ph_lo, ph_hi; };
typedef const __attribute__((address_space(4))) Args* ArgP;

__device__ __forceinline__ void convert_weights(ArgP a, int l, LAS unsigned char* lds, int gw, int NGW, int wave, int lane) {
    unsigned char* wb = a->ws + OFF_W;
    LAS float* scr = (LAS float*)(lds + wave * 16384);
    constexpr int I_FI = 16 * 176, I_FO = 44 * 32, I_WI = 16 * 61, I_WO = 16 * 32, I_UQ = 4 * 18, I_UKV = 2 * 24, I_LRU = 48;
    constexpr int NIT = 2 * I_FI + 2 * I_FO + I_WI + I_WO + I_UQ + I_UKV + I_LRU;
    for (int it = gw; it < NIT; it += NGW) {
        int r = it;
        if (r < I_FI) { transpose_item<1>(a->in[7] + (size_t)l * D * 2 * DFF, 2 * DFF, (bf16_t*)(wb + W_FFN1_IN), D, scr, r, lane); continue; } r -= I_FI;
        if (r < I_FI) { transpose_item<1>(a->in[29] + (size_t)l * D * 2 * DFF, 2 * DFF, (bf16_t*)(wb + W_FFN2_IN), D, scr, r, lane); continue; } r -= I_FI;
        if (r < I_FO) { transpose_item<0>(a->in[8] + (size_t)l * DFF * D, D, (bf16_t*)(wb + W_FFN1_OUT), DFF, scr, r, lane); continue; } r -= I_FO;
        if (r < I_FO) { transpose_item<0>(a->in[30] + (size_t)l * DFF * D, D, (bf16_t*)(wb + W_FFN2_OUT), DFF, scr, r, lane); continue; } r -= I_FO;
        if (r < I_WI) { transpose_item<0>(a->in[10] + (size_t)l * D * INW, INW, (bf16_t*)(wb + W_IN), D, scr, r, lane); continue; } r -= I_WI;
        if (r < I_WO) { transpose_item<0>(a->in[11] + (size_t)l * D * D, D, (bf16_t*)(wb + W_OUT), D, scr, r, lane); continue; } r -= I_WO;
        if (r < I_UQ) { transpose_item<0>(a->in[20] + (size_t)l * 256 * 576, 576, (bf16_t*)(wb + W_UQ), 256, scr, r, lane); continue; } r -= I_UQ;
        if (r < I_UKV) { transpose_item<0>(a->in[22] + (size_t)l * 128 * 768, 768, (bf16_t*)(wb + W_UKV), 256, scr, r, lane); continue; } r -= I_UKV;
        { const int mat = r >> 1, sub = r & 1, ax = (mat / 6) & 1, dir = mat / 12, n = mat % 6;
          const float* src = (ax ? a->in[16] : a->in[14]) + (size_t)((l * 2 + dir) * 6 + n) * 4096;
          transpose_item<0>(src, 64, (bf16_t*)(wb + W_LRU) + (size_t)mat * 4096, 64, scr, sub, lane); }
    }
    const int gt = gw * 64 + lane, GT = NGW * 64; unsigned zz = 0u; asm volatile("" : "+v"(zz)); const u32x4 z = {zz, zz, zz, zz};
    for (int i = gt; i < 12288; i += GT) *(u32x4*)(wb + W_IN + (size_t)1952 * 1024 * 2 + (size_t)i * 16) = z;
    for (int i = gt; i < 6144; i += GT) *(u32x4*)(wb + W_UQ + (size_t)576 * 256 * 2 + (size_t)i * 16) = z;
    for (int i = gt; i < 12288; i += GT) *(u32x4*)(wb + W_UKV + (size_t)(i >> 4) * 512 + 256 + (i & 15) * 16) = z;
}

__device__ __forceinline__ void p0_phase(ArgP a, LAS unsigned char* lds, int tid, int wave, int lane, int bid, int G) {
    const int gt = bid * NTHR + tid, GT = G * NTHR;
    { const f32x4* xs = (const f32x4*)a->in[0]; f32x4* xd = (f32x4*)a->out;
      for (int i = gt; i < MLAT * D / 4; i += GT) xd[i] = xs[i];
      const f32x4* cs = (const f32x4*)a->in[2]; f32x4* cd = (f32x4*)(a->ws + OFF_HC);
      for (int i = gt; i < NB * C * D / 4; i += GT) cd[i] = cs[i]; }
    if (bid == 0) {
        float* rope = (float*)(a->ws + OFF_ROPE);
        for (int i = tid; i < 1024; i += NTHR) { const int pos = i >> 3, j = i & 7;
            const float invs[8] = {1.0f, 0.31622776f, 0.1f, 0.031622775f, 0.01f, 0.0031622776f, 0.001f, 0.00031622776f};
            float inv = invs[0];
#pragma unroll
            for (int q = 1; q < 8; ++q) inv = (j == q) ? invs[q] : inv;
            const float x = (float)pos * inv;
            const float q = rintf(x * 0.63661977236758134f); const int n = (int)q;
            float rr = fmaf(-q, 1.5703125f, x); rr = fmaf(-q, 4.837512969970703125e-4f, rr); rr = fmaf(-q, 7.54978995489188216e-8f, rr);
            const float r2 = rr * rr;
            const float sr = rr + rr * r2 * (-1.6666654611e-1f + r2 * (8.3321608736e-3f + r2 * (-1.9515295891e-4f)));
            const float cr = 1.0f - 0.5f * r2 + r2 * r2 * (4.166664568298827e-2f + r2 * (-1.388731625493765e-3f + r2 * (2.443315711809948e-5f)));
            float s, c; const int qd = n & 3;
            if (qd == 0) { s = sr; c = cr; } else if (qd == 1) { s = cr; c = -sr; } else if (qd == 2) { s = -sr; c = -cr; } else { s = -cr; c = sr; }
            rope[2 * i] = c; rope[2 * i + 1] = s; }
    }
    LAS float* sl = (LAS float*)lds; LAS float* red = (LAS float*)(lds + 5 * 1024 * 4);
    for (int i = tid; i < 5 * 1024; i += NTHR) { const int mi = i >> 10, k = i & 1023; const float v = mi < 4 ? a->in[1][mi * 1024 + k] : a->in[3][k]; sl[i] = v * sigmoidf_(v); }
    __syncthreads();
    float* MOD = (float*)(a->ws + OFF_MOD);
    for (int item = bid; item < 576; item += G) {
        const int l = item / 144, n0 = (item % 144) * 64;
        const float* wp = a->in[4] + (size_t)l * 1024 * 9216 + n0 + lane;
        float ac[5] = {0.f, 0.f, 0.f, 0.f, 0.f};
#pragma unroll 8
        for (int kk = 0; kk < 128; ++kk) { const int k = wave * 128 + kk; const float wv = wp[(size_t)k * 9216];
#pragma unroll
            for (int mi = 0; mi < 5; ++mi) ac[mi] += sl[mi * 1024 + k] * wv; }
#pragma unroll
        for (int mi = 0; mi < 5; ++mi) red[(wave * 5 + mi) * 64 + lane] = ac[mi];
        __syncthreads();
        if (tid < 320) { const int mi = tid >> 6; float s = 0.f;
#pragma unroll
            for (int w = 0; w < 8; ++w) s += red[(w * 5 + mi) * 64 + lane];
            MOD[(size_t)(l * 5 + mi) * 9216 + n0 + lane] = s + a->in[5][l * 9216 + n0 + lane]; }
        __syncthreads();
    }
}

__device__ __forceinline__ void norm_phase(const float* hl, const float* hc, const float* __restrict__ g, const float* __restrict__ modl, int sh_chunk, bf16_t* XN, int gw, int NGW, int lane, int nrows, const float* part, int npieces) {
    for (int rr = gw; rr < nrows; rr += NGW) {
        const int row = nrows - 1 - rr;
        const float* xr = row < MLAT ? hl + (size_t)row * D : hc + (size_t)(row - MLAT) * D;
        const int mi = row < MLAT ? (row >> 13) : 4;
        const float* shift = modl + mi * 9216 + sh_chunk * 1024; const float* scale = shift + 1024;
        f32x4 v[4]; float s = 0.f;
#pragma unroll
        for (int j = 0; j < 4; ++j) v[j] = *(const f32x4*)(xr + 4 * lane + 256 * j);
        if (row >= MLAT && npieces > 0) {
            for (int p = 0; p < npieces; ++p) { const float* pr = part + ((size_t)p * 1024 + (row - MLAT)) * D + 4 * lane;
#pragma unroll
                for (int j = 0; j < 4; ++j) v[j] = v[j] + *(const f32x4*)(pr + 256 * j); }
#pragma unroll
            for (int j = 0; j < 4; ++j) *(f32x4*)(const_cast<float*>(xr) + 4 * lane + 256 * j) = v[j];
        }
#pragma unroll
        for (int j = 0; j < 4; ++j) s += (v[j].x * v[j].x + v[j].y * v[j].y) + (v[j].z * v[j].z + v[j].w * v[j].w);
        const float rstd = 1.f / sqrtf(wave_sum(s) * (1.f / D) + EPS);
#pragma unroll
        for (int j = 0; j < 4; ++j) { const int k = 4 * lane + 256 * j;
            const f32x4 gg = *(const f32x4*)(g + k), sc = *(const f32x4*)(scale + k), sh = *(const f32x4*)(shift + k);
            const f32x4 y = (v[j] * rstd) * gg * (sc + 1.f) + sh;
            u32x2 o; o.x = pk2(y.x, y.y); o.y = pk2(y.z, y.w);
            *(u32x2*)(XN + (size_t)row * D + k) = o; }
    }
}

struct TileGeo { int R0, b, p0, s0, seglen, latent; };
__device__ __forceinline__ TileGeo tile_geo(int tl) {
    TileGeo g; g.R0 = tl * 64; g.latent = tl < 512;
    if (g.latent) { g.b = tl >> 7; g.s0 = (tl & 127) * 64; g.p0 = 256 + g.s0; g.seglen = T; }
    else { g.b = (tl - 512) >> 2; g.s0 = ((tl - 512) & 3) * 64; g.p0 = g.s0; g.seglen = C; }
    return g;
}

constexpr int XC_STR = 388;
__device__ __forceinline__ void lru_conv_tile(ArgP a, int l, const TileGeo& g, LAS float* xc, int tid) {
    if (tid < 384) {
        const bf16_t* Z = (const bf16_t*)(a->ws + OFF_Z) + (size_t)g.R0 * INW + Z_LX + tid;
        const float* cw = a->in[12] + (size_t)l * 4 * 384 + tid;
        const float w0 = cw[0], w1 = cw[384], w2 = cw[768], w3 = cw[1152], cb = a->in[13][l * 384 + tid];
        float xm2 = (g.s0 - 2 >= 0) ? bf2f(Z[(ptrdiff_t)(-2) * INW]) : 0.f;
        float xm1 = (g.s0 - 1 >= 0) ? bf2f(Z[(ptrdiff_t)(-1) * INW]) : 0.f;
        float x0 = bf2f(Z[0]);
        for (int i0 = 0; i0 < 64; i0 += 16) {
            float xn[16];
#pragma unroll
            for (int k = 0; k < 16; ++k) xn[k] = (g.s0 + i0 + k + 1 < g.seglen) ? bf2f(Z[(ptrdiff_t)(i0 + k + 1) * INW]) : 0.f;
#pragma unroll
            for (int k = 0; k < 16; ++k) { xc[(i0 + k) * XC_STR + tid] = cb + w0 * xm2 + w1 * xm1 + w2 * x0 + w3 * xn[k]; xm2 = xm1; xm1 = x0; x0 = xn[k]; }
        }
    }
}
template <bool FINAL>
__device__ __forceinline__ void lru_tasks(ArgP a, int l, const TileGeo& g, const LAS float* xc, int wave, int lane) {
    const int r = lane & 31, h = lane >> 5;
    const bf16_t* WL = (const bf16_t*)(a->ws + OFF_W + W_LRU);
    const float2* SUMS = (const float2*)(a->ws + OFF_LRUS); const float* CARRY = (const float*)(a->ws + OFF_LRUC);
    for (int task = wave; task < 24; task += NWAVES) {
        const int sub = task / 12, cgp = task % 12, n = cgp >> 1, chalf = cgp & 1;
        const int ch = 32 * cgp + r;
        const int chunk = (g.p0 >> 5) + sub;
        bf16x8 af[4];
#pragma unroll
        for (int ks = 0; ks < 4; ++ks) { const LAS float* xp = xc + (32 * sub + r) * XC_STR + 64 * n + 16 * ks + 8 * h;
            const f32x4 v0 = *(const LAS f32x4*)xp, v1 = *(const LAS f32x4*)(xp + 4);
            u32x4 w; w.x = pk2(v0.x, v0.y); w.y = pk2(v0.z, v0.w); w.z = pk2(v1.x, v1.y); w.w = pk2(v1.z, v1.w); af[ks] = __builtin_bit_cast(bf16x8, w); }
        float xv[16];
#pragma unroll
        for (int v = 0; v < 16; ++v) xv[v] = xc[(32 * sub + (v & 3) + 8 * (v >> 2) + 4 * h) * XC_STR + ch];
        float y[16];
#pragma unroll
        for (int v = 0; v < 16; ++v) y[v] = 0.f;
#pragma unroll
        for (int dir = 0; dir < 2; ++dir) {
            f32x16 pa, px;
#pragma unroll
            for (int v = 0; v < 16; ++v) { pa[v] = 0.f; px[v] = 0.f; }
            const bf16_t* wa = WL + (size_t)((dir * 2 + 0) * 6 + n) * 4096 + (32 * chalf + r) * 64 + 8 * h;
            const bf16_t* wx = WL + (size_t)((dir * 2 + 1) * 6 + n) * 4096 + (32 * chalf + r) * 64 + 8 * h;
#pragma unroll
            for (int ks = 0; ks < 4; ++ks) { const bf16x8 ba = *(const bf16x8*)(wa + 16 * ks), bx = *(const bf16x8*)(wx + 16 * ks);
                pa = MFMA32(af[ks], ba, pa); px = MFMA32(af[ks], bx, px); }
            const float ba_ = a->in[15][(l * 2 + dir) * 384 + ch], bx_ = a->in[17][(l * 2 + dir) * 384 + ch], lam = a->in[18][(l * 2 + dir) * 384 + ch];
            const float k1 = -8.0f * LOG2E * log1pf(__expf(-lam));
            float av[16], uv[16];
#pragma unroll
            for (int v = 0; v < 16; ++v) { const float rg = sigmoidf_(pa[v] + ba_), ig = sigmoidf_(px[v] + bx_);
                const float l2 = k1 * rg, aa = __builtin_amdgcn_exp2f(l2); av[v] = aa;
                const float x2 = l2 * 1.3862943611198906f;
                const float pl = x2 * (1.f + x2 * (0.5f + x2 * (0.16666667f + x2 * (0.041666668f + x2 * (0.0083333338f + x2 * 0.0013888889f)))));
                const float om = x2 > -0.25f ? -pl : fmaf(-aa, aa, 1.0f);
                uv[v] = __builtin_amdgcn_sqrtf(om) * (ig * xv[v]); }
            float GA[4], GU[4];
#pragma unroll
            for (int q = 0; q < 4; ++q) { float A = 1.f, U = 0.f;
#pragma unroll
                for (int cc = 0; cc < 4; ++cc) { const int c2 = dir == 0 ? cc : 3 - cc; const int v = 4 * q + c2; U = av[v] * U + uv[v]; A = av[v] * A; }
                GA[q] = A; GU[q] = U; }
            float OA[4], OU[4];
#pragma unroll
            for (int q = 0; q < 4; ++q) { OA[q] = xhalf(GA[q]); OU[q] = xhalf(GU[q]); }
            float LA[8], LU[8];
#pragma unroll
            for (int q = 0; q < 4; ++q) { LA[2 * q] = h == 0 ? GA[q] : OA[q]; LU[2 * q] = h == 0 ? GU[q] : OU[q]; LA[2 * q + 1] = h == 1 ? GA[q] : OA[q]; LU[2 * q + 1] = h == 1 ? GU[q] : OU[q]; }
            if (!FINAL) {
                float A = 1.f, U = 0.f;
#pragma unroll
                for (int gg = 0; gg < 8; ++gg) { const int gi = dir == 0 ? gg : 7 - gg; U = LA[gi] * U + LU[gi]; A = LA[gi] * A; }
                if (h == 0) { float2 o; o.x = A; o.y = U; ((float2*)SUMS)[(size_t)((g.b * 2 + dir) * NCHUNK + chunk) * 384 + ch] = o; }
            } else {
                float X = CARRY[(size_t)((g.b * 2 + dir) * NCHUNK + chunk) * 384 + ch];
                float XS[8];
#pragma unroll
                for (int gg = 0; gg < 8; ++gg) { const int gi = dir == 0 ? gg : 7 - gg; XS[gi] = X; X = LA[gi] * X + LU[gi]; }
#pragma unroll
                for (int q = 0; q < 4; ++q) { float x = h == 0 ? XS[2 * q] : XS[2 * q + 1];
#pragma unroll
                    for (int cc = 0; cc < 4; ++cc) { const int c2 = dir == 0 ? cc : 3 - cc; const int v = 4 * q + c2; x = av[v] * x + uv[v]; y[v] += x; } }
            }
        }
        if (FINAL) {
            const bf16_t* Z = (const bf16_t*)(a->ws + OFF_Z); bf16_t* Y = (bf16_t*)(a->ws + OFF_XN);
#pragma unroll
            for (int v = 0; v < 16; ++v) { const int row = g.R0 + 32 * sub + (v & 3) + 8 * (v >> 2) + 4 * h;
                const float lg = bf2f(Z[(size_t)row * INW + Z_LG + ch]);
                const float ge = lg * sigmoidf_(1.5957691216057308f * (lg + 0.044715f * lg * lg * lg));
                Y[(size_t)row * D + ch] = (bf16_t)f2bf(y[v] * ge); }
        }
    }
}
__device__ __forceinline__ void lru_carry(ArgP a, int item, int lane) {
    const int bd = item / 6, ch = 64 * (item % 6) + lane, dir = bd & 1;
    const float2* S = (const float2*)(a->ws + OFF_LRUS) + (size_t)bd * NCHUNK * 384 + ch; float* Cr = (float*)(a->ws + OFF_LRUC) + (size_t)bd * NCHUNK * 384 + ch;
    float X = 0.f;
    for (int i0 = 0; i0 < NCHUNK; i0 += 8) {
        float2 s[8]; int ck[8];
#pragma unroll
        for (int j = 0; j < 8; ++j) { const int i = i0 + j;
            ck[j] = dir == 0 ? i : (i < 8 ? 7 - i : NCHUNK + 7 - i); s[j] = S[(size_t)ck[j] * 384]; }
#pragma unroll
        for (int j = 0; j < 8; ++j) { Cr[(size_t)ck[j] * 384] = X; X = s[j].x * X + s[j].y; }
    }
}

constexpr int LRU_CW_OFF = 65536, LRU_T_OFF = 73728, LRU_T_STR = 65;
template <bool FINAL>
__device__ __forceinline__ void lru_wave_phase(ArgP a, int l, LAS unsigned char* lds, int gw, int NGW, int wave, int lane, int tid, int nchunks = 1056) {
    LAS float* cw = (LAS float*)(lds + LRU_CW_OFF);
    for (int i = tid; i < 5 * 384; i += NTHR) cw[i] = i < 1536 ? a->in[12][l * 1536 + i] : a->in[13][l * 384 + (i - 1536)];
    __syncthreads();
    const int NWG = NGW / 12;
    if (gw < NWG * 12) {
        const int g = gw % 12, n = g >> 1, chalf = g & 1, r = lane & 31, h = lane >> 5, ch = 32 * g + r;
        const bf16_t* WL = (const bf16_t*)(a->ws + OFF_W + W_LRU); const bf16_t* Z = (const bf16_t*)(a->ws + OFF_Z);
        bf16x8 wfa[2][4], wfx[2][4]; float ba_[2], bx_[2], k1[2];
#pragma unroll
        for (int dir = 0; dir < 2; ++dir) {
            const bf16_t* wa = WL + (size_t)((dir * 2 + 0) * 6 + n) * 4096 + (32 * chalf + r) * 64 + 8 * h; const bf16_t* wx = WL + (size_t)((dir * 2 + 1) * 6 + n) * 4096 + (32 * chalf + r) * 64 + 8 * h;
#pragma unroll
            for (int ks = 0; ks < 4; ++ks) { wfa[dir][ks] = *(const bf16x8*)(wa + 16 * ks); wfx[dir][ks] = *(const bf16x8*)(wx + 16 * ks); }
            ba_[dir] = a->in[15][(l * 2 + dir) * 384 + ch]; bx_[dir] = a->in[17][(l * 2 + dir) * 384 + ch];
            k1[dir] = -8.0f * LOG2E * log1pf(__expf(-a->in[18][(l * 2 + dir) * 384 + ch]));
        }
        LAS float* Tw = (LAS float*)(lds + LRU_T_OFF) + wave * (32 * LRU_T_STR);
        const LAS float* cwl = cw + 64 * n + 8 * h;
        for (int cid = gw / 12; cid < nchunks; cid += NWG) {
            int b, cs, R0, seglen, chunk;
            if (cid < 1024) { b = cid >> 8; cs = cid & 255; R0 = b * T + 32 * cs; seglen = T; chunk = 8 + cs; } else { const int q = cid - 1024; b = q >> 3; cs = q & 7; R0 = MLAT + b * C + 32 * cs; seglen = C; chunk = cs; }
            const int s0 = 32 * cs;
            bf16x8 af[4];
#pragma unroll
            for (int kp = 0; kp < 2; ++kp) {
                u32x4 ux[4][2];
#pragma unroll
                for (int t = 0; t < 4; ++t) { const int sp = s0 + r + t - 2; const bool ok = sp >= 0 && sp < seglen; const bf16_t* zr = Z + (ptrdiff_t)(R0 + r + t - 2) * INW + 64 * n + 8 * h + 32 * kp;
#pragma unroll
                    for (int k2 = 0; k2 < 2; ++k2) { u32x4 u = {0u, 0u, 0u, 0u}; if (ok) u = *(const u32x4*)(zr + 16 * k2); ux[t][k2] = u; } }
#pragma unroll
                for (int k2 = 0; k2 < 2; ++k2) { const int ks = 2 * kp + k2; float cv[8];
                    { const f32x4 b0 = *(const LAS f32x4*)(cwl + 1536 + 16 * ks), b1 = *(const LAS f32x4*)(cwl + 1536 + 16 * ks + 4);
                      cv[0] = b0.x; cv[1] = b0.y; cv[2] = b0.z; cv[3] = b0.w; cv[4] = b1.x; cv[5] = b1.y; cv[6] = b1.z; cv[7] = b1.w; }
#pragma unroll
                    for (int t = 0; t < 4; ++t) { const f32x4 w0 = *(const LAS f32x4*)(cwl + t * 384 + 16 * ks), w1 = *(const LAS f32x4*)(cwl + t * 384 + 16 * ks + 4); const u32x4 u = ux[t][k2];
                        cv[0] += w0.x * bflo(u.x); cv[1] += w0.y * bfhi(u.x); cv[2] += w0.z * bflo(u.y); cv[3] += w0.w * bfhi(u.y);
                        cv[4] += w1.x * bflo(u.z); cv[5] += w1.y * bfhi(u.z); cv[6] += w1.z * bflo(u.w); cv[7] += w1.w * bfhi(u.w); }
                    { u32x4 w; w.x = pk2(cv[0], cv[1]); w.y = pk2(cv[2], cv[3]); w.z = pk2(cv[4], cv[5]); w.w = pk2(cv[6], cv[7]); af[ks] = __builtin_bit_cast(bf16x8, w); }
                    LAS float* tp = Tw + r * LRU_T_STR + 16 * ks + 8 * h;
#pragma unroll
                    for (int j = 0; j < 8; ++j) tp[j] = cv[j];
                }
            }
            float xv[16];
#pragma unroll
            for (int v = 0; v < 16; ++v) xv[v] = Tw[((v & 3) + 8 * (v >> 2) + 4 * h) * LRU_T_STR + 32 * chalf + r];
            float y[16];
#pragma unroll
            for (int v = 0; v < 16; ++v) y[v] = 0.f;
#pragma unroll
            for (int dir = 0; dir < 2; ++dir) {
                f32x16 pa, px;
#pragma unroll
                for (int v = 0; v < 16; ++v) { pa[v] = 0.f; px[v] = 0.f; }
#pragma unroll
                for (int ks = 0; ks < 4; ++ks) { pa = MFMA32(af[ks], wfa[dir][ks], pa); px = MFMA32(af[ks], wfx[dir][ks], px); }
                float av[16], uv[16];
#pragma unroll
                for (int v = 0; v < 16; ++v) { const float rg = sigmoidf_(pa[v] + ba_[dir]), ig = sigmoidf_(px[v] + bx_[dir]);
                    const float l2 = k1[dir] * rg, aa = __builtin_amdgcn_exp2f(l2); av[v] = aa;
                    const float x2 = l2 * 1.3862943611198906f;
                    const float pl = x2 * (1.f + x2 * (0.5f + x2 * (0.16666667f + x2 * (0.041666668f + x2 * (0.0083333338f + x2 * 0.0013888889f)))));
                    const float om = x2 > -0.25f ? -pl : fmaf(-aa, aa, 1.0f);
                    uv[v] = __builtin_amdgcn_sqrtf(om) * (ig * xv[v]); }
                float GA[4], GU[4];
#pragma unroll
                for (int q = 0; q < 4; ++q) { float A = 1.f, U = 0.f;
#pragma unroll
                    for (int cc = 0; cc < 4; ++cc) { const int c2 = dir == 0 ? cc : 3 - cc; const int v = 4 * q + c2; U = av[v] * U + uv[v]; A = av[v] * A; }
                    GA[q] = A; GU[q] = U; }
                float OA[4], OU[4];
#pragma unroll
                for (int q = 0; q < 4; ++q) { OA[q] = xhalf(GA[q]); OU[q] = xhalf(GU[q]); }
                float LA[8], LU[8];
#pragma unroll
                for (int q = 0; q < 4; ++q) { LA[2 * q] = h == 0 ? GA[q] : OA[q]; LU[2 * q] = h == 0 ? GU[q] : OU[q]; LA[2 * q + 1] = h == 1 ? GA[q] : OA[q]; LU[2 * q + 1] = h == 1 ? GU[q] : OU[q]; }
                if (!FINAL) {
                    float A = 1.f, U = 0.f;
#pragma unroll
                    for (int gg = 0; gg < 8; ++gg) { const int gi = dir == 0 ? gg : 7 - gg; U = LA[gi] * U + LU[gi]; A = LA[gi] * A; }
                    if (h == 0) { float2 o; o.x = A; o.y = U; ((float2*)(a->ws + OFF_LRUS))[(size_t)((b * 2 + dir) * NCHUNK + chunk) * 384 + ch] = o; }
                } else {
                    float X = ((const float*)(a->ws + OFF_LRUC))[(size_t)((b * 2 + dir) * NCHUNK + chunk) * 384 + ch];
                    float XE[4];
#pragma unroll
                    for (int q = 0; q < 4; ++q) XE[q] = 0.f;
#pragma unroll
                    for (int gg = 0; gg < 8; ++gg) { const int gi = dir == 0 ? gg : 7 - gg; if ((gi & 1) == h) XE[gi >> 1] = X; X = LA[gi] * X + LU[gi]; }
#pragma unroll
                    for (int q = 0; q < 4; ++q) { float x = XE[q];
#pragma unroll
                        for (int cc = 0; cc < 4; ++cc) { const int c2 = dir == 0 ? cc : 3 - cc; const int v = 4 * q + c2; x = av[v] * x + uv[v]; y[v] += x; } }
                }
            }
            if (FINAL) {
#pragma unroll
                for (int v = 0; v < 16; ++v) Tw[((v & 3) + 8 * (v >> 2) + 4 * h) * LRU_T_STR + r] = y[v];
                const bf16_t* zl = Z + (size_t)(R0 + r) * INW + Z_LG + 32 * g + 16 * h;
                const u32x4 l0 = *(const u32x4*)zl, l1 = *(const u32x4*)(zl + 8);
                const unsigned lw[8] = {l0.x, l0.y, l0.z, l0.w, l1.x, l1.y, l1.z, l1.w}; unsigned ow[8];
#pragma unroll
                for (int j = 0; j < 8; ++j) { const float y0 = Tw[r * LRU_T_STR + 16 * h + 2 * j], y1 = Tw[r * LRU_T_STR + 16 * h + 2 * j + 1]; const float g0 = bflo(lw[j]), g1 = bfhi(lw[j]);
                    const float e0 = g0 * sigmoidf_(1.5957691216057308f * (g0 + 0.044715f * g0 * g0 * g0)), e1 = g1 * sigmoidf_(1.5957691216057308f * (g1 + 0.044715f * g1 * g1 * g1));
                    ow[j] = pk2(y0 * e0, y1 * e1); }
                bf16_t* yo = (bf16_t*)(a->ws + OFF_XN) + (size_t)(R0 + r) * D + 32 * g + 16 * h;
                u32x4 o0 = {ow[0], ow[1], ow[2], ow[3]}, o1 = {ow[4], ow[5], ow[6], ow[7]}; *(u32x4*)yo = o0; *(u32x4*)(yo + 8) = o1;
            }
        }
    }
    __syncthreads();
}

__device__ __forceinline__ void mixprep_rows(ArgP a, int l, int gw, int NGW, int lane) {
    const bf16_t* Z = (const bf16_t*)(a->ws + OFF_Z);
    const float* qn = a->in[19] + l * 256; const float* kvn = a->in[21] + l * 128; const float* nqg = a->in[25] + l * 64; const float* nkg = a->in[26] + l * 64;
    const float nscale = 0.125f * LOG2E;
    const f32x4 gq = *(const f32x4*)(qn + 4 * lane); const float gkv0 = kvn[2 * lane], gkv1 = kvn[2 * lane + 1];
    const int hd = lane >> 4, d0 = 4 * (lane & 15);
    const f32x4 gnq = *(const f32x4*)(nqg + d0), gnk = *(const f32x4*)(nkg + d0);
    for (int row0 = gw * 4; row0 < MTOT; row0 += NGW * 4) {
        u32x2 ucq[4], unq[4], unk[4]; unsigned uckv[4];
#pragma unroll
        for (int t4 = 0; t4 < 4; ++t4) { const bf16_t* zr = Z + (size_t)(row0 + t4) * INW;
            ucq[t4] = *(const u32x2*)(zr + Z_CQ + 4 * lane); uckv[t4] = *(const unsigned*)(zr + Z_CKV + 2 * lane);
            unq[t4] = *(const u32x2*)(zr + Z_NQ + 4 * lane); unk[t4] = *(const u32x2*)(zr + Z_NK + 4 * lane); }
#pragma unroll
        for (int t4 = 0; t4 < 4; ++t4) {
            const int row = row0 + t4; int b, p; if (row < MLAT) { b = row >> 13; p = 256 + (row & 8191); } else { b = (row - MLAT) >> 8; p = (row - MLAT) & 255; }
            { const u32x2 u = ucq[t4]; float v0 = bflo(u.x), v1 = bfhi(u.x), v2 = bflo(u.y), v3 = bfhi(u.y);
              const float rstd = 1.f / sqrtf(wave_sum(v0 * v0 + v1 * v1 + v2 * v2 + v3 * v3) * (1.f / 256) + EPS);
              u32x2 o; o.x = pk2(v0 * rstd * gq.x, v1 * rstd * gq.y); o.y = pk2(v2 * rstd * gq.z, v3 * rstd * gq.w);
              *(u32x2*)((bf16_t*)(a->ws + OFF_CQN) + (size_t)row * 256 + 4 * lane) = o; }
            { const unsigned u = uckv[t4]; float v0 = bflo(u), v1 = bfhi(u);
              const float rstd = 1.f / sqrtf(wave_sum(v0 * v0 + v1 * v1) * (1.f / 128) + EPS);
              bf16_t* o = (bf16_t*)(a->ws + OFF_CKVN) + (size_t)row * 256;
              *(unsigned*)(o + 2 * lane) = pk2(v0 * rstd * gkv0, v1 * rstd * gkv1); *(unsigned*)(o + 128 + 2 * lane) = 0u; }
            { const u32x2 u = unq[t4]; float v0 = bflo(u.x), v1 = bfhi(u.x), v2 = bflo(u.y), v3 = bfhi(u.y);
              float sq = v0 * v0 + v1 * v1 + v2 * v2 + v3 * v3; sq = row16_sum(sq);
              const float rstd = nscale / sqrtf(sq * (1.f / 64) + EPS);
              u32x2 o; o.x = pk2(v0 * rstd * gnq.x, v1 * rstd * gnq.y); o.y = pk2(v2 * rstd * gnq.z, v3 * rstd * gnq.w);
              *(u32x2*)((bf16_t*)(a->ws + OFF_NQ) + ((size_t)(b * 4 + hd) * P + p) * 64 + d0) = o; }
            { const u32x2 u = unk[t4]; float v0 = bflo(u.x), v1 = bfhi(u.x), v2 = bflo(u.y), v3 = bfhi(u.y);
              float sq = v0 * v0 + v1 * v1 + v2 * v2 + v3 * v3; sq = row16_sum(sq);
              const float rstd = 1.f / sqrtf(sq * (1.f / 64) + EPS);
              u32x2 o; o.x = pk2(v0 * rstd * gnk.x, v1 * rstd * gnk.y); o.y = pk2(v2 * rstd * gnk.z, v3 * rstd * gnk.w);
              *(u32x2*)((bf16_t*)(a->ws + OFF_NK) + ((size_t)(b * 4 + hd) * P + p) * 64 + d0) = o; }
        }
    }
}
constexpr int NVT_STR = 516;
__device__ __forceinline__ void mixprep_tile(ArgP a, int l, int tl, LAS unsigned char* lds, int tid, int wave, int lane, int pm) {
    const TileGeo g = tile_geo(tl);
    LAS unsigned char* nvt = lds;
    const bf16_t* Z = (const bf16_t*)(a->ws + OFF_Z);
    { u32x2 unv[8];
#pragma unroll
      for (int ii = 0; ii < 8; ++ii) unv[ii] = *(const u32x2*)(Z + (size_t)(g.R0 + wave * 8 + ii) * INW + Z_NV + 4 * lane);
#pragma unroll
      for (int ii = 0; ii < 8; ++ii) { const int i = wave * 8 + ii; *(LAS unsigned*)(nvt + i * NVT_STR + 8 * lane) = unv[ii].x; *(LAS unsigned*)(nvt + i * NVT_STR + 8 * lane + 4) = unv[ii].y; } }
    __syncthreads();
    {
        const int rowid = tid >> 1, half = tid & 1; unsigned w[16];
#pragma unroll
        for (int j = 0; j < 16; ++j) { const unsigned lo = *(const LAS bf16_t*)(nvt + (half * 32 + 2 * j) * NVT_STR + rowid * 2), hi = *(const LAS bf16_t*)(nvt + (half * 32 + 2 * j + 1) * NVT_STR + rowid * 2); w[j] = lo | (hi << 16); }
        bf16_t* dst = (bf16_t*)(a->ws + OFF_NVT) + ((size_t)(g.b * 4 + (rowid >> 6)) * 64 + (rowid & 63)) * P + g.p0 + 32 * half;
#pragma unroll
        for (int j = 0; j < 4; ++j) { u32x4 o = {w[4 * j], w[4 * j + 1], w[4 * j + 2], w[4 * j + 3]}; *(u32x4*)(dst + 8 * j) = o; }
    }
    __syncthreads();
}

__device__ __forceinline__ void mlapost_rows(ArgP a, int l, int gw, int NGW, int lane) {
    const bf16_t* Z = (const bf16_t*)(a->ws + OFF_Z); const bf16_t* QR = (const bf16_t*)(a->ws + OFF_QRAW); const bf16_t* KVR = (const bf16_t*)(a->ws + OFF_KVRAW);
    const float* rope = (const float*)(a->ws + OFF_ROPE);
    const float qscale = 0.10206207261596575f * LOG2E;
    const int rw = lane >> 4, c = lane & 15; const bool act = c < 12, isrope = c >= 8 && c < 12;
    const int cc = act ? c : 0;
    const f32x4 gq0 = *(const f32x4*)(a->in[23] + l * 96 + 8 * cc), gq1 = *(const f32x4*)(a->in[23] + l * 96 + 8 * cc + 4);
    const f32x4 gk0 = *(const f32x4*)(a->in[24] + l * 96 + 8 * cc), gk1 = *(const f32x4*)(a->in[24] + l * 96 + 8 * cc + 4);
    const int axis = (c >> 1) & 1, hf = c & 1;
    constexpr int NGRP = MTOT * 12 / 4;
    for (int g0 = gw * 4; g0 < NGRP; g0 += NGW * 4) {
        u32x4 uin[4];
#pragma unroll
        for (int u = 0; u < 4; ++u) { const int item = (g0 + u) * 4 + rw; const size_t row = (size_t)(item / 12); const int hq = item % 12;
            const bf16_t* src = hq < 6 ? QR + row * 576 + hq * 96 + 8 * cc : (cc < 8 ? KVR + row * 768 + (hq - 6) * 128 + 8 * cc : Z + row * INW + Z_KR + 8 * (cc - 8));
            uin[u] = *(const u32x4*)src; }
#pragma unroll
        for (int u = 0; u < 4; ++u) { const int item = (g0 + u) * 4 + rw; const int row = item / 12, hq = item % 12; const bool isq = hq < 6; const int hh = isq ? hq : hq - 6;
            int b, p, t; const bool latent = row < MLAT;
            if (latent) { b = row >> 13; t = row & 8191; p = 256 + t; } else { b = (row - MLAT) >> 8; p = (row - MLAT) & 255; t = 0; }
            float v[8]; v[0] = bflo(uin[u].x); v[1] = bfhi(uin[u].x); v[2] = bflo(uin[u].y); v[3] = bfhi(uin[u].y); v[4] = bflo(uin[u].z); v[5] = bfhi(uin[u].z); v[6] = bflo(uin[u].w); v[7] = bfhi(uin[u].w);
            float ss = 0.f;
#pragma unroll
            for (int j = 0; j < 8; ++j) ss += v[j] * v[j];
            ss = act ? ss : 0.f;
            const float rstd = 1.f / sqrtf(row16_sum(ss) * (1.f / 96) + EPS);
            const f32x4 ga = isq ? gq0 : gk0, gb = isq ? gq1 : gk1;
            v[0] *= rstd * ga.x; v[1] *= rstd * ga.y; v[2] *= rstd * ga.z; v[3] *= rstd * ga.w; v[4] *= rstd * gb.x; v[5] *= rstd * gb.y; v[6] *= rstd * gb.z; v[7] *= rstd * gb.w;
            float o[8];
#pragma unroll
            for (int j = 0; j < 8; ++j) o[j] = dppf<0xB1>(v[j]);
            if (latent && isrope) { const int pos = axis == 0 ? (t >> 6) : (t & 63); const float* rp = rope + pos * 16;
                const f32x4 r0 = *(const f32x4*)rp, r1 = *(const f32x4*)(rp + 4), r2 = *(const f32x4*)(rp + 8), r3 = *(const f32x4*)(rp + 12);
                const float cs[8] = {r0.x, r0.z, r1.x, r1.z, r2.x, r2.z, r3.x, r3.z}, sn[8] = {r0.y, r0.w, r1.y, r1.w, r2.y, r2.w, r3.y, r3.w};
#pragma unroll
                for (int j = 0; j < 8; ++j) v[j] = hf == 0 ? v[j] * cs[j] - o[j] * sn[j] : v[j] * cs[j] + o[j] * sn[j]; }
            const float sc = isq ? qscale : 1.0f;
            u32x4 w; w.x = pk2(v[0] * sc, v[1] * sc); w.y = pk2(v[2] * sc, v[3] * sc); w.z = pk2(v[4] * sc, v[5] * sc); w.w = pk2(v[6] * sc, v[7] * sc);
            bf16_t* dst = (bf16_t*)(a->ws + (isq ? OFF_QM : OFF_KM)) + ((size_t)(b * 6 + hh) * P + p) * 96 + 8 * cc;
            if (act) *(u32x4*)dst = w; }
    }
}
constexpr int MVT_STR = 784;
__device__ __forceinline__ void mlapost_tile(ArgP a, int l, int tl, LAS unsigned char* lds, int tid, int wave, int lane, int pm) {
    const TileGeo g = tile_geo(tl);
    const bf16_t* KVR = (const bf16_t*)(a->ws + OFF_KVRAW);
    { u32x4 uv[6];
#pragma unroll
      for (int k = 0; k < 6; ++k) { const int idx = tid + k * NTHR, tok = idx / 48, ch = idx % 48; uv[k] = *(const u32x4*)(KVR + (size_t)(g.R0 + tok) * 768 + (ch >> 3) * 128 + 64 + (ch & 7) * 8); }
#pragma unroll
      for (int k = 0; k < 6; ++k) { const int idx = tid + k * NTHR, tok = idx / 48, ch = idx % 48; *(LAS u32x4*)(lds + tok * MVT_STR + ch * 16) = uv[k]; } }
    __syncthreads();
    for (int rowid = tid >> 1; rowid < 384; rowid += 256) { const int half = tid & 1; unsigned w[16];
#pragma unroll
        for (int j = 0; j < 16; ++j) { const unsigned lo = *(const LAS bf16_t*)(lds + (half * 32 + 2 * j) * MVT_STR + rowid * 2), hi = *(const LAS bf16_t*)(lds + (half * 32 + 2 * j + 1) * MVT_STR + rowid * 2); w[j] = lo | (hi << 16); }
        bf16_t* dst = (bf16_t*)(a->ws + OFF_VMT) + ((size_t)(g.b * 6 + rowid / 64) * 64 + (rowid & 63)) * P + g.p0 + 32 * half;
#pragma unroll
        for (int j = 0; j < 4; ++j) { u32x4 o = {w[4 * j], w[4 * j + 1], w[4 * j + 2], w[4 * j + 3]}; *(u32x4*)(dst + 8 * j) = o; }
    }
    __syncthreads();
}

__device__ __forceinline__ float max3f(float a, float b, float c) { float r; asm("v_max3_f32 %0, %1, %2, %3" : "=v"(r) : "v"(a), "v"(b), "v"(c)); return r; }
__device__ __forceinline__ unsigned pkrtz(float lo, float hi) { return __builtin_bit_cast(unsigned, __builtin_amdgcn_cvt_pkrtz(lo, hi)); }
template <bool NA>
__device__ __forceinline__ void att_softmax_pv(f32x16& S0, f32x16& S1, const float mref, f32x16& O0, f32x16& O1, f32x16& O2, float& mrun, const LAS unsigned char* vb, int r, int h, bool local, const LAS float* bp, int wst) {
    if (NA && local) {
#pragma unroll
        for (int v = 0; v < 16; ++v) { const int kc0 = 16 * (v >> 3) + 8 * h + (v & 7), kc1 = kc0 + 32;
            S0[v] = (kc0 >= wst && kc0 < wst + 16) ? S0[v] + bp[kc0] : -INFINITY; S1[v] = (kc1 >= wst && kc1 < wst + 16) ? S1[v] + bp[kc1] : -INFINITY; }
    }
    float mx = max3f(S0[0], S0[1], S0[2]);
    mx = max3f(mx, S0[3], S0[4]); mx = max3f(mx, S0[5], S0[6]); mx = max3f(mx, S0[7], S0[8]); mx = max3f(mx, S0[9], S0[10]); mx = max3f(mx, S0[11], S0[12]); mx = max3f(mx, S0[13], S0[14]);
    mx = max3f(mx, S0[15], S1[0]); mx = max3f(mx, S1[1], S1[2]); mx = max3f(mx, S1[3], S1[4]); mx = max3f(mx, S1[5], S1[6]); mx = max3f(mx, S1[7], S1[8]); mx = max3f(mx, S1[9], S1[10]);
    mx = max3f(mx, S1[11], S1[12]); mx = max3f(mx, S1[13], S1[14]); mx = fmaxf(mx, S1[15]);
    mx = xhalf_max(mx);
    const float mabs = mref + mx;
    if (__builtin_amdgcn_ballot_w64((mref != mrun) || ((mabs - mrun) > 8.0f)) != 0ull) {
        const float mnew = fmaxf(mrun, mabs), alpha = __builtin_amdgcn_exp2f(mrun - mnew), d = mnew - mref; mrun = mnew;
#pragma unroll
        for (int v = 0; v < 16; ++v) { O0[v] *= alpha; O1[v] *= alpha; O2[v] *= alpha; S0[v] -= d; S1[v] -= d; }
    }
    bf16x8 pf[4];
    { float e0[16], e1[16];
#pragma unroll
      for (int v = 0; v < 16; ++v) { e0[v] = __builtin_amdgcn_exp2f(S0[v]); e1[v] = __builtin_amdgcn_exp2f(S1[v]); }
      u32x4 w;
      w.x = pkrtz(e0[0], e0[1]); w.y = pkrtz(e0[2], e0[3]); w.z = pkrtz(e0[4], e0[5]); w.w = pkrtz(e0[6], e0[7]); pf[0] = __builtin_bit_cast(bf16x8, w);
      w.x = pkrtz(e0[8], e0[9]); w.y = pkrtz(e0[10], e0[11]); w.z = pkrtz(e0[12], e0[13]); w.w = pkrtz(e0[14], e0[15]); pf[1] = __builtin_bit_cast(bf16x8, w);
      w.x = pkrtz(e1[0], e1[1]); w.y = pkrtz(e1[2], e1[3]); w.z = pkrtz(e1[4], e1[5]); w.w = pkrtz(e1[6], e1[7]); pf[2] = __builtin_bit_cast(bf16x8, w);
      w.x = pkrtz(e1[8], e1[9]); w.y = pkrtz(e1[10], e1[11]); w.z = pkrtz(e1[12], e1[13]); w.w = pkrtz(e1[14], e1[15]); pf[3] = __builtin_bit_cast(bf16x8, w); }
    const bf16x8 ones = {0x3C00, 0x3C00, 0x3C00, 0x3C00, 0x3C00, 0x3C00, 0x3C00, 0x3C00};
#pragma unroll
    for (int kk = 0; kk < 4; ++kk) { const bf16x8 v0 = *(const LAS bf16x8*)(vb + r * 144 + kk * 32 + h * 16), v1 = *(const LAS bf16x8*)(vb + (32 + r) * 144 + kk * 32 + h * 16);
        O0 = MFMA32(v0, pf[kk], O0); O1 = MFMA32(v1, pf[kk], O1); O2 = MFMA32(ones, pf[kk], O2); }
}
template <int DQK, bool NA>
__device__ __forceinline__ void attn_unit(LAS unsigned char* lds, const bf16_t* __restrict__ Qb, const bf16_t* __restrict__ Kb, const bf16_t* __restrict__ Vtb,
                                          bf16_t* __restrict__ Yb  , int qb, const LAS float* rpbh, int tid) {
    constexpr int KSTR = (DQK + 8) * 2, VSTR = 144, KBUF = 64 * KSTR, VBUF = 64 * VSTR, KPR = DQK / 8, NKP = 64 * KPR, NKS = DQK / 16;
    static_assert(2 * KBUF + 2 * VBUF <= 49152, "attention LDS");
    const int wave = tid >> 6, lane = tid & 63, r = lane & 31, h = lane >> 5;
    int n_tiles, rlo = 0;
    if (qb == 0) n_tiles = 4;
    else if (!NA) n_tiles = P / 64;
    else { const int R = 4 * (qb - 1); rlo = clampi(R - 4, 0, 120); const int rhi = clampi(R - 1, 0, 120) + 7; n_tiles = 4 + rhi - rlo + 1; }
    const int wrow = 4 * (qb - 1) + (wave >> 1);
    const int r0w = clampi(wrow - 4, 0, 120);
    const int qc = 32 * (wave & 1) + r, wst = clampi(qc - 8, 0, 48);
    const int pq = 256 * qb + 32 * wave + r;
    bf16x8 qf[NKS];
#pragma unroll
    for (int ks = 0; ks < NKS; ++ks) qf[ks] = *(const bf16x8*)(Qb + (size_t)pq * DQK + 16 * ks + 8 * h);
    f32x16 O0, O1, O2;
#pragma unroll
    for (int v = 0; v < 16; ++v) { O0[v] = 0.f; O1[v] = 0.f; O2[v] = 0.f; }
    float mrun = -1e30f;
    const int krow = (r & ~12) | ((r & 4) << 1) | ((r & 8) >> 1);
#define ATT_TILE(it) ((NA && (it) >= 4) ? 4 + rlo + ((it) - 4) : (it))
#define ATT_ACT(it) (!(NA && (it) >= 4) || ((rlo + (it) - 4) >= r0w && (rlo + (it) - 4) <= r0w + 7))
#define ATT_LOADK(it, K0_, K1_) do { const bf16_t* kp_ = Kb + (size_t)ATT_TILE(it) * 64 * DQK; K0_ = *(const u32x4*)(kp_ + tid * 8); \
        if (NKP > 512) { if (tid < NKP - 512) K1_ = *(const u32x4*)(kp_ + (tid + 512) * 8); } } while (0)
#define ATT_LOADV(it, V_) do { V_ = *(const u32x4*)(Vtb + (size_t)(tid >> 3) * P + ATT_TILE(it) * 64 + (tid & 7) * 8); } while (0)
#define ATT_STOREK(slot, K0_, K1_) do { LAS unsigned char* bb_ = lds + (slot) * KBUF; *(LAS u32x4*)(bb_ + (tid / KPR) * KSTR + (tid % KPR) * 16) = K0_; \
        if (NKP > 512) { if (tid < NKP - 512) { const int i_ = tid + 512; *(LAS u32x4*)(bb_ + (i_ / KPR) * KSTR + (i_ % KPR) * 16) = K1_; } } } while (0)
#define ATT_STOREV(slot, V_) do { *(LAS u32x4*)(lds + 2 * KBUF + (slot) * VBUF + (tid >> 3) * VSTR + (tid & 7) * 16) = V_; } while (0)
#define ATT_QK(Sa, Sb, slot, mref_) do { const LAS unsigned char* kb_ = lds + (slot) * KBUF; const float ni_ = -(mref_); _Pragma("unroll") for (int v = 0; v < 16; ++v) { Sa[v] = ni_; Sb[v] = ni_; } \
        _Pragma("unroll") for (int ks = 0; ks < NKS; ++ks) { const bf16x8 a0 = *(const LAS bf16x8*)(kb_ + krow * KSTR + ks * 32 + h * 16), a1 = *(const LAS bf16x8*)(kb_ + (32 + krow) * KSTR + ks * 32 + h * 16); \
            Sa = MFMA32(a0, qf[ks], Sa); Sb = MFMA32(a1, qf[ks], Sb); } } while (0)
#define ATT_BODY(it, C0, C1, mrefC, N0, N1, mrefN, LK0, LK1, LV, SK0, SK1, SV) do { \
        if ((it) + 3 < n_tiles) ATT_LOADK((it) + 3, LK0, LK1); \
        if ((it) + 2 < n_tiles) ATT_LOADV((it) + 2, LV); \
        mrefN = (it) == 0 ? 0.f : mrun;                                \
        if (!NA || ((it) + 1 < n_tiles && ATT_ACT((it) + 1))) ATT_QK(N0, N1, ((it) + 1) & 1, mrefN);     \
        if (ATT_ACT(it)) { const int kr_ = rlo + (it) - 4; \
            att_softmax_pv<NA>(C0, C1, mrefC, O0, O1, O2, mrun, lds + 2 * KBUF + ((it) & 1) * VBUF, r, h, NA && (it) >= 4, rpbh + (kr_ - wrow + 7) * 31 + 15 - qc, wst); } \
        if ((it) + 2 < n_tiles) ATT_STOREK((it) & 1, SK0, SK1); \
        if ((it) + 1 < n_tiles) ATT_STOREV(((it) + 1) & 1, SV); \
        __syncthreads(); } while (0)
    u32x4 ka0, ka1 = {0u, 0u, 0u, 0u}, va, kb0, kb1 = {0u, 0u, 0u, 0u}, vb;
    ATT_LOADK(0, ka0, ka1); ATT_LOADV(0, va); ATT_LOADK(1, kb0, kb1);
    ATT_STOREK(0, ka0, ka1); ATT_STOREV(0, va); ATT_STOREK(1, kb0, kb1);
    ATT_LOADK(2, kb0, kb1); ATT_LOADV(1, vb);
    __syncthreads();
    f32x16 A0, A1, B0, B1; float mrefA = 0.f, mrefB = 0.f;
    ATT_QK(A0, A1, 0, mrefA);
    for (int it = 0; it < n_tiles; it += 2) {
        ATT_BODY(it, A0, A1, mrefA, B0, B1, mrefB, ka0, ka1, va, kb0, kb1, vb);
        if (it + 1 < n_tiles) ATT_BODY(it + 1, B0, B1, mrefB, A0, A1, mrefA, kb0, kb1, vb, ka0, ka1, va);
    }
#undef ATT_TILE
#undef ATT_ACT
#undef ATT_LOADK
#undef ATT_LOADV
#undef ATT_STOREK
#undef ATT_STOREV
#undef ATT_QK
#undef ATT_BODY
    const float inv = 1.f / O2[0];
    bf16_t* yr = Yb + (size_t)(32 * wave + r) * D;
#pragma unroll
    for (int q = 0; q < 4; ++q) { u32x2 o;
        o.x = pg8::cvt_pk_bf16(O0[4 * q] * inv, O0[4 * q + 1] * inv); o.y = pg8::cvt_pk_bf16(O0[4 * q + 2] * inv, O0[4 * q + 3] * inv); *(u32x2*)(yr + 8 * q + 4 * h) = o;
        o.x = pg8::cvt_pk_bf16(O1[4 * q] * inv, O1[4 * q + 1] * inv); o.y = pg8::cvt_pk_bf16(O1[4 * q + 2] * inv, O1[4 * q + 3] * inv); *(u32x2*)(yr + 32 + 8 * q + 4 * h) = o; }
}

__device__ __forceinline__ void att64_softmax(f32x16& S0, f32x16& S1, f32x16& O0, f32x16& O1, float& mrun, float& lsum, bf16x8 (&pf)[4], const bool first) {
    float mx = max3f(S0[0], S0[1], S0[2]);
    mx = max3f(mx, S0[3], S0[4]); mx = max3f(mx, S0[5], S0[6]); mx = max3f(mx, S0[7], S0[8]); mx = max3f(mx, S0[9], S0[10]); mx = max3f(mx, S0[11], S0[12]); mx = max3f(mx, S0[13], S0[14]);
    mx = max3f(mx, S0[15], S1[0]); mx = max3f(mx, S1[1], S1[2]); mx = max3f(mx, S1[3], S1[4]); mx = max3f(mx, S1[5], S1[6]); mx = max3f(mx, S1[7], S1[8]); mx = max3f(mx, S1[9], S1[10]);
    mx = max3f(mx, S1[11], S1[12]); mx = max3f(mx, S1[13], S1[14]); mx = fmaxf(mx, S1[15]);
    mx = xhalf_max(mx);
    if (first || __builtin_amdgcn_ballot_w64(mx > 8.0f) != 0ull) {
        const float d = first ? mx : fmaxf(mx, 0.f), alpha = first ? 0.f : __builtin_amdgcn_exp2f(-d); mrun += d; lsum *= alpha;
#pragma unroll
        for (int v = 0; v < 16; ++v) { O0[v] *= alpha; O1[v] *= alpha; S0[v] -= d; S1[v] -= d; }
    }
    float e0[16], e1[16]; float ps = 0.f;
#pragma unroll
    for (int v = 0; v < 16; ++v) { e0[v] = __builtin_amdgcn_exp2f(S0[v]); e1[v] = __builtin_amdgcn_exp2f(S1[v]); ps += e0[v] + e1[v]; }
    lsum += ps;
    u32x4 w;
    w.x = pkrtz(e0[0], e0[1]); w.y = pkrtz(e0[2], e0[3]); w.z = pkrtz(e0[4], e0[5]); w.w = pkrtz(e0[6], e0[7]); pf[0] = __builtin_bit_cast(bf16x8, w);
    w.x = pkrtz(e0[8], e0[9]); w.y = pkrtz(e0[10], e0[11]); w.z = pkrtz(e0[12], e0[13]); w.w = pkrtz(e0[14], e0[15]); pf[1] = __builtin_bit_cast(bf16x8, w);
    w.x = pkrtz(e1[0], e1[1]); w.y = pkrtz(e1[2], e1[3]); w.z = pkrtz(e1[4], e1[5]); w.w = pkrtz(e1[6], e1[7]); pf[2] = __builtin_bit_cast(bf16x8, w);
    w.x = pkrtz(e1[8], e1[9]); w.y = pkrtz(e1[10], e1[11]); w.z = pkrtz(e1[12], e1[13]); w.w = pkrtz(e1[14], e1[15]); pf[3] = __builtin_bit_cast(bf16x8, w);
}
__device__ __forceinline__ void attn_unit_mla64(LAS unsigned char* lds, const bf16_t* __restrict__ Qb, const bf16_t* __restrict__ Kb, const bf16_t* __restrict__ Vtb, bf16_t* __restrict__ Yb  , int qb, int tid_in) {
    constexpr int DQK = 96, KSTR = 208, VSTR = 144, KBUF = 64 * KSTR, VBUF = 64 * VSTR, NKS = 6;
    int tid = tid_in; asm volatile("" : "+v"(tid));
    const int wave = tid >> 6, lane = tid & 63, r = lane & 31, h = lane >> 5;
    constexpr int n_tiles = P / 64;
    const int pq = 256 + 512 * qb + 64 * wave + r;
    bf16x8 qa[NKS], qc[NKS];
#pragma unroll
    for (int ks = 0; ks < NKS; ++ks) { qa[ks] = *(const bf16x8*)(Qb + (size_t)pq * DQK + 16 * ks + 8 * h); qc[ks] = *(const bf16x8*)(Qb + (size_t)(pq + 32) * DQK + 16 * ks + 8 * h); }
    f32x16 Oa0, Oa1, Oc0, Oc1;
#pragma unroll
    for (int v = 0; v < 16; ++v) { Oa0[v] = 0.f; Oa1[v] = 0.f; Oc0[v] = 0.f; Oc1[v] = 0.f; }
    float mra = -1e30f, mrc = -1e30f, lsa = 0.f, lsc = 0.f;
    const int krow = (r & ~12) | ((r & 4) << 1) | ((r & 8) >> 1);
    u32x4 k0, k1 = {0u, 0u, 0u, 0u}, vv;
#define A6_LOAD(it) do { const bf16_t* kp_ = Kb + (size_t)(it) * 64 * DQK; k0 = *(const u32x4*)(kp_ + tid * 8); if (tid < 256) k1 = *(const u32x4*)(kp_ + (tid + 512) * 8); \
        vv = *(const u32x4*)(Vtb + (size_t)(tid >> 3) * P + (it) * 64 + (tid & 7) * 8); } while (0)
#define A6_STORE(slot) do { LAS unsigned char* bb_ = lds + (slot) * KBUF; *(LAS u32x4*)(bb_ + (tid / 12) * KSTR + (tid % 12) * 16) = k0; \
        if (tid < 256) { const int i_ = tid + 512; *(LAS u32x4*)(bb_ + (i_ / 12) * KSTR + (i_ % 12) * 16) = k1; } \
        *(LAS u32x4*)(lds + 2 * KBUF + (slot) * VBUF + (tid >> 3) * VSTR + (tid & 7) * 16) = vv; } while (0)
    A6_LOAD(0); A6_STORE(0);
    __syncthreads();
    for (int it = 0; it < n_tiles; ++it) {
        if (it + 1 < n_tiles) A6_LOAD(it + 1);
        const LAS unsigned char* kb_ = lds + (it & 1) * KBUF; const LAS unsigned char* vb_ = lds + 2 * KBUF + (it & 1) * VBUF;
        f32x16 Sa0, Sa1, Sc0, Sc1;
        { const float na = it == 0 ? 0.f : -mra, nc = it == 0 ? 0.f : -mrc;
#pragma unroll
          for (int v = 0; v < 16; ++v) { Sa0[v] = na; Sa1[v] = na; Sc0[v] = nc; Sc1[v] = nc; } }
#pragma unroll
        for (int ks = 0; ks < NKS; ++ks) { const bf16x8 a0 = *(const LAS bf16x8*)(kb_ + krow * KSTR + ks * 32 + h * 16), a1 = *(const LAS bf16x8*)(kb_ + (32 + krow) * KSTR + ks * 32 + h * 16);
            Sa0 = MFMA32(a0, qa[ks], Sa0); Sa1 = MFMA32(a1, qa[ks], Sa1); Sc0 = MFMA32(a0, qc[ks], Sc0); Sc1 = MFMA32(a1, qc[ks], Sc1); }
        if (it == 0) { mra = 0.f; mrc = 0.f; }
        bf16x8 pa[4], pc[4];
        att64_softmax(Sa0, Sa1, Oa0, Oa1, mra, lsa, pa, it == 0);
        att64_softmax(Sc0, Sc1, Oc0, Oc1, mrc, lsc, pc, it == 0);
#pragma unroll
        for (int kk = 0; kk < 4; ++kk) { const bf16x8 v0 = *(const LAS bf16x8*)(vb_ + r * VSTR + kk * 32 + h * 16), v1 = *(const LAS bf16x8*)(vb_ + (32 + r) * VSTR + kk * 32 + h * 16);
            Oa0 = MFMA32(v0, pa[kk], Oa0); Oa1 = MFMA32(v1, pa[kk], Oa1); Oc0 = MFMA32(v0, pc[kk], Oc0); Oc1 = MFMA32(v1, pc[kk], Oc1); }
        if (it + 1 < n_tiles) A6_STORE((it + 1) & 1);
        __syncthreads();
    }
#undef A6_LOAD
#undef A6_STORE
    const float inva = 1.f / xhalf_sum(lsa), invc = 1.f / xhalf_sum(lsc);
    bf16_t* ya = Yb + (size_t)(64 * wave + r) * D; bf16_t* yc = ya + (size_t)32 * D;
#pragma unroll
    for (int q = 0; q < 4; ++q) { u32x2 o;
        o.x = pg8::cvt_pk_bf16(Oa0[4 * q] * inva, Oa0[4 * q + 1] * inva); o.y = pg8::cvt_pk_bf16(Oa0[4 * q + 2] * inva, Oa0[4 * q + 3] * inva); *(u32x2*)(ya + 8 * q + 4 * h) = o;
        o.x = pg8::cvt_pk_bf16(Oa1[4 * q] * inva, Oa1[4 * q + 1] * inva); o.y = pg8::cvt_pk_bf16(Oa1[4 * q + 2] * inva, Oa1[4 * q + 3] * inva); *(u32x2*)(ya + 32 + 8 * q + 4 * h) = o;
        o.x = pg8::cvt_pk_bf16(Oc0[4 * q] * invc, Oc0[4 * q + 1] * invc); o.y = pg8::cvt_pk_bf16(Oc0[4 * q + 2] * invc, Oc0[4 * q + 3] * invc); *(u32x2*)(yc + 8 * q + 4 * h) = o;
        o.x = pg8::cvt_pk_bf16(Oc1[4 * q] * invc, Oc1[4 * q + 1] * invc); o.y = pg8::cvt_pk_bf16(Oc1[4 * q + 2] * invc, Oc1[4 * q + 3] * invc); *(u32x2*)(yc + 32 + 8 * q + 4 * h) = o; }
}

#define XB_TMO      128
#define XB_XCNT(j)  (256  + 64 * (j))
#define XB_XSUB(j)  (1280 + 64 * (j))
#define XB_XGEN(j)  (2304 + 64 * (j))
#define XB_TOP      3328
#define XB_TOPGEN   3392
#define XCD_BAR_WORDS 3456
#define XB_SPIN_CAP (1u << 18)

__device__ __forceinline__ unsigned xb_ld(unsigned* p)              { return __hip_atomic_load(p, __ATOMIC_RELAXED, __HIP_MEMORY_SCOPE_AGENT); }
__device__ __forceinline__ unsigned xb_add(unsigned* p, unsigned v) { return __hip_atomic_fetch_add(p, v, __ATOMIC_RELAXED, __HIP_MEMORY_SCOPE_AGENT); }
__device__ __forceinline__ unsigned xb_xcc_id() { return (unsigned)__builtin_amdgcn_s_getreg((3 << 11) | 20) & 0xFu; }
#define XB_SPIN(cond, bar) do { unsigned _sp = 0; while (cond) { __builtin_amdgcn_s_sleep(1); \
    if ((++_sp & 255u) == 0u) { if (xb_ld(&(bar)[XB_TMO])) break; if (_sp > XB_SPIN_CAP) { atomicAdd(&(bar)[XB_TMO], 1u); break; } } } } while (0)

struct XcdBarrier {
    unsigned* bar; unsigned x;
    volatile LAS unsigned* st;
};

__device__ __forceinline__ XcdBarrier xcd_barrier_post(unsigned* bar, volatile LAS unsigned* st, int tid) {
    XcdBarrier b; b.bar = bar; b.x = xb_xcc_id(); b.st = st;
    if (tid == 0) (void)xb_add(&bar[XB_XCNT(b.x)], 1u);
    return b;
}
__device__ __forceinline__ void xcd_barrier_complete(unsigned* bar, unsigned x, unsigned& nloc, unsigned& nx) {
    const unsigned G = gridDim.x * gridDim.y * gridDim.z;
    unsigned sum, cnt, mine, sp = 0u;
    for (;;) {
        sum = 0u; cnt = 0u; mine = 0u;
#pragma unroll
        for (unsigned j = 0; j < 16; ++j) { const unsigned c = xb_ld(&bar[XB_XCNT(j)]); sum += c; cnt += (c > 0u) ? 1u : 0u; mine = (j == x) ? c : mine; }
        if (sum == G) break;
        __builtin_amdgcn_s_sleep(1);
        if ((++sp & 255u) == 0u) { if (xb_ld(&bar[XB_TMO])) break; if (sp > XB_SPIN_CAP) { atomicAdd(&bar[XB_TMO], 1u); break; } }
    }
    nloc = mine > 0u ? mine : 1u; nx = cnt > 0u ? cnt : 1u;
}

__device__ __forceinline__ void xcd_barrier(const XcdBarrier& b, int tid) {
    asm volatile("s_waitcnt vmcnt(0)" ::: "memory");
    __syncthreads();
    if (tid == 0) {
        unsigned* bar = b.bar;
        __builtin_amdgcn_s_waitcnt(0);
        unsigned nloc = b.st[0], nx = b.st[1];
        if (nloc == 0u) { xcd_barrier_complete(bar, b.x, nloc, nx); b.st[0] = nloc; b.st[1] = nx; }
        const unsigned old = xb_add(&bar[XB_XSUB(b.x)], 1u);
        const unsigned gen = old / nloc;
        if (old + 1u == (gen + 1u) * nloc) {
            __builtin_amdgcn_fence(__ATOMIC_RELEASE, "agent");
            asm volatile("s_waitcnt vmcnt(0)" ::: "memory");
            const unsigned og = xb_add(&bar[XB_TOP], 1u);
            const unsigned tg = og / nx;
            if (og + 1u == (tg + 1u) * nx) xb_add(&bar[XB_TOPGEN], 1u);
            else XB_SPIN(xb_ld(&bar[XB_TOPGEN]) == tg, bar);
            __builtin_amdgcn_fence(__ATOMIC_ACQUIRE, "agent");
            xb_add(&bar[XB_XGEN(b.x)], 1u);
            asm volatile("s_waitcnt vmcnt(0)" ::: "memory");
        } else {
            XB_SPIN(xb_ld(&bar[XB_XGEN(b.x)]) == gen, bar);
            __builtin_amdgcn_fence(__ATOMIC_ACQUIRE, "agent");
            asm volatile("s_waitcnt vmcnt(0)" ::: "memory");
        }
    }
    __syncthreads();
}

__global__ void __launch_bounds__(NTHR) fwd_megakernel(Args a_unused) {
    extern __shared__ __attribute__((aligned(16))) unsigned char lds_raw[];
    cg::grid_group grid = cg::this_grid();
    const int ph_lo = a_unused.ph_lo, ph_hi = a_unused.ph_hi;
    const int wave0 = __builtin_amdgcn_readfirstlane((int)(threadIdx.x >> 6));
    XcdBarrier xbar;
    { volatile LAS unsigned* st = (volatile LAS unsigned*)((LAS unsigned char*)lds_raw + LDS_BYTES - 64);
      if (threadIdx.x < 2) st[threadIdx.x] = 0u;
      __syncthreads();
      xbar = xcd_barrier_post((unsigned*)(a_unused.ws + OFF_BAR), st, (int)threadIdx.x); }
    int rep = 0; (void)rep;
    for (int ph = ph_lo; ph < ph_hi; ++ph) {
        ArgP a = (ArgP)__builtin_amdgcn_kernarg_segment_ptr();
        asm volatile("" : "+s"(a));
        LAS unsigned char* lds = (LAS unsigned char*)lds_raw;
        int bid = blockIdx.x, G = gridDim.x, wave = wave0;
        asm volatile("" : "+s"(bid)); asm volatile("" : "+s"(G)); asm volatile("" : "+s"(wave));
        const int gw = bid * NWAVES + wave, NGW = G * NWAVES;
#define GETLANE() int lane; asm volatile("v_mbcnt_lo_u32_b32 %0, -1, 0\n\tv_mbcnt_hi_u32_b32 %0, -1, %0" : "=v"(lane)); const int tid = wave * 64 + lane
#if defined(PROBE_PARTS)
        const int pm = rep ? PROBE_PARTS : 7;
#else
        const int pm = 7;
#endif
        unsigned char* ws = a->ws;
        float* hl = a->out; float* hc = (float*)(ws + OFF_HC);
        bf16_t* XN = (bf16_t*)(ws + OFF_XN);
        unsigned char* wb = ws + OFF_W;
        if (ph == 0) { GETLANE(); p0_phase(a, lds, tid, wave, lane, bid, G); }
        else {
            const int l = (ph - 1) / 13, j = (ph - 1) % 13;
            const float* modl = (const float*)(ws + OFF_MOD) + (size_t)l * 5 * 9216;
            const int nctx = (l == DEPTH - 1 && j >= 9) ? 0 : 4;
            if (j == 0) { GETLANE(); (void)tid; convert_weights(a, l, lds, gw, NGW, wave, lane); norm_phase(hl, hc, a->in[6] + l * D, modl, 0, XN, gw, NGW, lane, MTOT, (const float*)(ws + OFF_PART), l > 0 ? 11 : 0); }
            else if (j == 3) { GETLANE(); (void)tid; norm_phase(hl, hc, a->in[9] + l * D, modl, 3, XN, gw, NGW, lane, MTOT, (const float*)(ws + OFF_PART), 11); }
            else if (j == 10) { GETLANE(); (void)tid; norm_phase(hl, hc, a->in[28] + l * D, modl, 6, XN, gw, NGW, lane, nctx ? MTOT : MLAT, (const float*)(ws + OFF_PART), nctx ? 4 : 0); }
            else if (j == 1 || j == 11) {
                GETLANE(); (void)lane;
                pg8::Gemm g{XN, (const bf16_t*)(wb + (j == 1 ? W_FFN1_IN : W_FFN2_IN)), MTOT, 2 * DFF, D}; CtxOrder S; S.init(2 * DFF, D, G, bid, nctx, 1);
                EpiSwiGLU E{(bf16_t*)(ws + OFF_HFF)}; pg8::gemm_phase<EpiSwiGLU, CtxOrder, true, true>(lds, g, S, E, tid); }
            else if (j == 2 || j == 9 || j == 12) {
                GETLANE(); (void)lane;
                const bf16_t* A = j == 9 ? XN : (const bf16_t*)(ws + OFF_HFF);
                const bf16_t* Bt = (const bf16_t*)(wb + (j == 2 ? W_FFN1_OUT : (j == 9 ? W_OUT : W_FFN2_OUT)));
                const int Kd = j == 9 ? D : DFF;
                pg8::Gemm g{A, Bt, MTOT, D, Kd}; CtxOrder S; S.init(D, Kd, G, bid, nctx, j == 9 ? 4 : 11);
                EpiResid E{hl, hc, modl + (j == 2 ? 2 : (j == 9 ? 5 : 8)) * 1024, j == 9 ? 1.0f : 0.5f}; pg8::gemm_phase<EpiResid, CtxOrder, true, true>(lds, g, S, E, tid); }
            else if (j == 4 || j == 6) {
                const int ng = j == 4 ? 1 : 2;
                for (int q = 0; q < ng; ++q) {
                    GETLANE(); (void)lane;
                    const bf16_t* A; const bf16_t* Bt; bf16_t* O; int N, K, ldc;
                    if (j == 4) { A = XN; Bt = (const bf16_t*)(wb + W_IN); O = (bf16_t*)(ws + OFF_Z); N = 2048; K = D; ldc = INW; }
                    else if (q == 0) { A = (const bf16_t*)(ws + OFF_CQN); Bt = (const bf16_t*)(wb + W_UQ); O = (bf16_t*)(ws + OFF_QRAW); N = 768; K = 256; ldc = 576; }
                    else { A = (const bf16_t*)(ws + OFF_CKVN); Bt = (const bf16_t*)(wb + W_UKV); O = (bf16_t*)(ws + OFF_KVRAW); N = 768; K = 256; ldc = 768; }
                    pg8::Gemm g{A, Bt, MTOT, N, K}; CtxOrder S; S.init(N, K, G, bid, 4, 1);
                    EpiStore E{O, ldc, ldc}; pg8::gemm_phase<EpiStore, CtxOrder, true, true>(lds, g, S, E, tid);
                } }
            else if (j == 5) { GETLANE(); if (pm & 1) mixprep_rows(a, l, gw, NGW, lane);
                if (pm & 4) for (int tl = bid; tl < 528; tl += G) mixprep_tile(a, l, tl, lds, tid, wave, lane, pm);
                if (pm & 2) lru_wave_phase<false>(a, l, lds, gw, NGW, wave, lane, tid); }
            else if (j == 7) {
                GETLANE();
                if (pm & 1) mlapost_rows(a, l, gw, NGW, lane);
                if (pm & 2) for (int tl = bid; tl < 528; tl += G) mlapost_tile(a, l, tl, lds, tid, wave, lane, pm);
                if ((pm & 4) && wave == 0) { for (int item = G - 1 - bid; item < 48; item += G) lru_carry(a, item, lane); } }
            else if (j == 8) {
                bf16_t* Y = XN;
                const int vb = (G & 7) == 0 ? (bid & 7) * (G >> 3) + (bid >> 3) : bid;
                if (pm & 1) { GETLANE(); (void)lane;
                    for (int u = vb; u < 256; u += G) {
                        int bh, idx; if (u < 176) { bh = u / 11; idx = u % 11; } else { const int v = u - 176; bh = 16 + v / 10; idx = v % 10; }
                        const int b = bh / 6, hh = bh % 6;
                        bf16_t* Yb = Y + (size_t)(b * T + 512 * idx) * D + 384 + hh * 64;
                        attn_unit_mla64(lds, (const bf16_t*)(ws + OFF_QM) + (size_t)bh * P * 96, (const bf16_t*)(ws + OFF_KM) + (size_t)bh * P * 96, (const bf16_t*)(ws + OFF_VMT) + (size_t)bh * 64 * P, Yb, idx, tid); }
                    for (int u = vb; u < 256; u += G) {
                        int bh, qs; if (u < 160) { bh = u / 10; qs = 5632 + 256 * (u % 10); } else { const int v = u - 160; bh = 16 + v / 12; qs = 5120 + 256 * (v % 12); }
                        const int b = bh / 6, hh = bh % 6;
                        bf16_t* Yb = Y + (size_t)(b * T + qs) * D + 384 + hh * 64;
                        attn_unit<96, false>(lds, (const bf16_t*)(ws + OFF_QM) + (size_t)bh * P * 96, (const bf16_t*)(ws + OFF_KM) + (size_t)bh * P * 96, (const bf16_t*)(ws + OFF_VMT) + (size_t)bh * 64 * P, Yb, 1 + qs / 256, nullptr, tid); }
                    if (l != DEPTH - 1) for (int u = vb; u < 24; u += G) {
                        const int b = u / 6, hh = u % 6; const size_t bh = (size_t)(b * 6 + hh);
                        bf16_t* Yb = Y + (size_t)(MLAT + b * C) * D + 384 + hh * 64;
                        attn_unit<96, false>(lds, (const bf16_t*)(ws + OFF_QM) + bh * P * 96, (const bf16_t*)(ws + OFF_KM) + bh * P * 96, (const bf16_t*)(ws + OFF_VMT) + bh * 64 * P, Yb, 0, nullptr, tid); }
                }
                { GETLANE(); (void)lane;
                LAS float* rpbl = (LAS float*)(lds + 49152);
                for (int i = tid; i < 4 * 465; i += NTHR) rpbl[i] = a->in[27][l * 4 * 465 + i] * LOG2E;
                __syncthreads();
                if (pm & 2) for (int u = vb; u < (l == DEPTH - 1 ? 512 : 528); u += G) {
                    int b, hh, qb; if (u < 512) { b = u / 128; hh = (u % 128) / 32; qb = 1 + (u & 31); } else { const int v = u - 512; b = v / 4; hh = v % 4; qb = 0; }
                    const size_t bh = (size_t)(b * 4 + hh);
                    bf16_t* Yb = Y + (size_t)(qb == 0 ? MLAT + b * C : b * T + 256 * (qb - 1)) * D + 768 + hh * 64;
                    attn_unit<64, true>(lds, (const bf16_t*)(ws + OFF_NQ) + bh * P * 64, (const bf16_t*)(ws + OFF_NK) + bh * P * 64, (const bf16_t*)(ws + OFF_NVT) + bh * 64 * P, Yb, qb, rpbl + hh * 465, tid);
                } }
                if (pm & 4) { GETLANE(); lru_wave_phase<true>(a, l, lds, gw, NGW, wave, lane, tid, l == DEPTH - 1 ? 1024 : 1056); }
            }
        }
#if defined(PROBE_SYNC2)
        if (ph + 1 < ph_hi) { GETLANE(); xcd_barrier(xbar, tid); }
#endif
#if defined(PROBE_REPEAT)
        if (ph > 0 && ((ph - 1) % 13) == PROBE_REPEAT && !rep) { rep = 1; --ph; } else rep = 0;
#endif
        if (ph + 1 < ph_hi) { if (ph == 0) grid.sync(); else { int l2; asm volatile("v_mbcnt_lo_u32_b32 %0, -1, 0\n\tv_mbcnt_hi_u32_b32 %0, -1, %0" : "=v"(l2)); xcd_barrier(xbar, wave0 * 64 + l2); } }
    }
}

extern "C" void kernel_launch(void* const* d_in, const int* in_sizes, int n_in, void* d_out, int out_size, void* d_ws, size_t ws_size, hipStream_t stream) {
    static int grid = 0;
    if (grid == 0) {
        if (n_in != 31 || out_size != MLAT * D || ws_size < WS_END2) { fprintf(stderr, "kernel_launch: unexpected problem (n_in %d, out %d, ws %zu < %zu)\n", n_in, out_size, ws_size, (size_t)WS_END2); grid = -1; return; }
        int dev = 0, cus = 0, per_cu = 0;
        hipGetDevice(&dev); hipDeviceGetAttribute(&cus, hipDeviceAttributeMultiprocessorCount, dev);
        if (hipFuncSetAttribute((const void*)fwd_megakernel, hipFuncAttributeMaxDynamicSharedMemorySize, LDS_BYTES) != hipSuccess) { fprintf(stderr, "kernel_launch: hipFuncSetAttribute failed\n"); grid = -1; return; }
        if (hipOccupancyMaxActiveBlocksPerMultiprocessor(&per_cu, (const void*)fwd_megakernel, NTHR, LDS_BYTES) != hipSuccess || per_cu < 1) { fprintf(stderr, "kernel_launch: occupancy query says %d\n", per_cu); per_cu = 1; }
        (void)hipGetLastError();
        grid = cus;
    }
    if (grid < 0) return;
    if (hipMemsetAsync((char*)d_ws + OFF_BAR, 0, XCD_BAR_WORDS * 4, stream) != hipSuccess) { fprintf(stderr, "kernel_launch: memset of the barrier words failed\n"); return; }
    Args a{};
    for (int i = 0; i < 31; ++i) a.in[i] = (const float*)d_in[i];
    a.out = (float*)d_out; a.ws = (unsigned char*)d_ws; a.ph_lo = 0; a.ph_hi = 1 + 13 * DEPTH;
    void* args[] = {&a};
    hipError_t e = hipLaunchCooperativeKernel((const void*)fwd_megakernel, dim3(grid), dim3(NTHR), args, LDS_BYTES, stream);
    if (e != hipSuccess) fprintf(stderr, "kernel_launch: cooperative launch failed: %s (grid %d)\n", hipGetErrorString(e), grid);
}
```

```cpp
#include <hip/hip_runtime.h>
#include <hip/hip_cooperative_groups.h>
#include <cstdio>
#include <cstdint>
namespace cg = cooperative_groups;
namespace pg8 {
#define PG8_LAS __attribute__((address_space(3)))
typedef unsigned short bf16_t;
typedef short bf16x8 __attribute__((ext_vector_type(8)));
typedef float f32x4 __attribute__((ext_vector_type(4)));
typedef unsigned u32x4 __attribute__((ext_vector_type(4)));
constexpr int BM = 256, BK = 64, HALF = 128, HTB = HALF * BK * 2  , STAGE_BYTES = 8 * HTB, NXCD = 8, WGM = 8;

__host__ __device__ __forceinline__ int lds_byte(int r, int c) { const int st = (r >> 4) * 2 + (c >> 5), rr = r & 15, cc = c & 31, ob = rr * 64 + cc * 2; return st * 1024 + (ob ^ (((ob >> 9) & 1) << 5)); }
__host__ __device__ __forceinline__ void stage_rc(int b, int& R, int& C) { const int st = b / 1024, sb = b % 1024, swz = sb ^ (((sb >> 9) & 1) << 5); R = (st >> 1) * 16 + swz / 64; C = (st & 1) * 32 + (swz % 64) / 2; }
__host__ __device__ __forceinline__ int perm32(int rho) { const int n = rho >> 4, i = rho & 15; return 8 * (i >> 2) + 4 * n + (i & 3); }

struct Unit { int pm, pn; };
struct Gemm { const bf16_t* A; const bf16_t* Bt; int M, N, K; };

struct StaticOrder {
    int nM, nN, nwg, G, c;
    __host__ __device__ void init(int M, int N, int G_, int c_) { nM = M / BM; nN = N / BM; nwg = nM * nN; G = G_; c = c_; }
    __host__ __device__ bool next(int i, Unit& u) const {
        const long L = (long)i * G + c; if (L >= nwg) return false;
        int wgid = (int)L; { const int q = nwg / NXCD, r = nwg % NXCD, xcd = wgid % NXCD, off = wgid / NXCD; wgid = (xcd < r ? xcd * (q + 1) : r * (q + 1) + (xcd - r) * q) + off; }
        const int nig = WGM * nN, gid = wgid / nig, fm = gid * WGM, gsz = (nM - fm) < WGM ? (nM - fm) : WGM;
        u.pm = fm + ((wgid % nig) % gsz); u.pn = (wgid % nig) / gsz; return true;
    }
    __device__ __forceinline__ void a_ready(const Unit&) const {}
    __device__ __forceinline__ void done(const Unit&) const {}
};

typedef _Float16 f16x8 __attribute__((ext_vector_type(8)));
typedef _Float16 f16x2 __attribute__((ext_vector_type(2)));
__device__ __forceinline__ unsigned cvt_pk_bf16(float lo, float hi) { f16x2 v; v.x = (_Float16)lo; v.y = (_Float16)hi; return __builtin_bit_cast(unsigned, v); }

template <class Epi, class Sched, bool ALIGN_EPI = false, bool SP2 = false>
__device__ __forceinline__ void gemm_phase(PG8_LAS unsigned char* lds, const Gemm g, const Sched& S, const Epi& E, const int tid_in) {
    const int tid = tid_in;
    const int wid = __builtin_amdgcn_readfirstlane(tid >> 6), lane = tid & 63, wr = wid >> 2, wc = wid & 3, fr = lane & 15, fq = lane >> 4;
    const int K = g.K;
    unsigned voffA[2], voffB[2];
#pragma unroll
    for (int i = 0; i < 2; ++i) { int R, C; stage_rc(tid * 16 + i * 8192, R, C); const int Rb = Epi::PERM ? ((R & ~31) + perm32(R & 31)) : R;
        voffA[i] = (unsigned)(R * K + C) * 2u; voffB[i] = (unsigned)(Rb * K + C) * 2u; }
    const size_t kstep = (size_t)(BK * 2);
    const size_t hstep = (size_t)HALF * K * 2;
    const size_t tstep = 2 * hstep;
    const unsigned ldsw = (unsigned)wid * 1024u;
    const int aoff = lds_byte(wr * 64 + fr, fq * 8), boff = lds_byte(wc * 32 + fr, fq * 8);
#define PG8_SA(b, h) (((b) * 2 + (h)) * HTB)
#define PG8_SB(b, h) ((4 + (b) * 2 + (h)) * HTB)
#define PG8_STAGE(bufoff, gbase, voff) do { _Pragma("unroll") for (int _i = 0; _i < 2; ++_i) \
        __builtin_amdgcn_global_load_lds((const unsigned*)((const char*)(gbase) + (voff)[_i]), (PG8_LAS unsigned*)(lds + (bufoff) + ldsw + _i * 8192), 16, 0, 0); } while (0)
#define PG8_LDA(dst, b, h) do { _Pragma("unroll") for (int m = 0; m < 4; ++m) _Pragma("unroll") for (int k = 0; k < 2; ++k) dst[m][k] = *(const PG8_LAS bf16x8*)(lds + PG8_SA(b, h) + aoff + m * 2048 + k * 1024); } while (0)
#define PG8_LDB(dst, b, h) do { _Pragma("unroll") for (int n = 0; n < 2; ++n) _Pragma("unroll") for (int k = 0; k < 2; ++k) dst[n][k] = *(const PG8_LAS bf16x8*)(lds + PG8_SB(b, h) + boff + n * 2048 + k * 1024); } while (0)
#define PG8_MMA(ai, bj, At, Bt) do { __builtin_amdgcn_s_setprio(1); _Pragma("unroll") for (int m = 0; m < 4; ++m) _Pragma("unroll") for (int n = 0; n < 2; ++n) _Pragma("unroll") for (int k = 0; k < 2; ++k) \
        acc[ai][bj][m][n] = __builtin_amdgcn_mfma_f32_16x16x32_f16(__builtin_bit_cast(f16x8, Bt[n][k]), __builtin_bit_cast(f16x8, At[m][k]), acc[ai][bj][m][n], 0, 0, 0); __builtin_amdgcn_s_setprio(0); } while (0)
#define PG8_WAIT_V(n) asm volatile("s_waitcnt vmcnt(" #n ")" ::: "memory")
#define PG8_WAIT_L(n) asm volatile("s_waitcnt lgkmcnt(" #n ")" ::: "memory")
#define PG8_BAR __builtin_amdgcn_s_barrier()
#define PG8_SCHED __builtin_amdgcn_sched_barrier(0)
    Unit cur, nxt; int ui = 0;
    if (!S.next(0, cur)) return;
    f32x4 acc[2][2][4][2];
#pragma unroll
    for (int a = 0; a < 2; ++a)
#pragma unroll
        for (int b = 0; b < 2; ++b)
#pragma unroll
            for (int m = 0; m < 4; ++m)
#pragma unroll
                for (int n = 0; n < 2; ++n) acc[a][b][m][n] = (f32x4){0.f, 0.f, 0.f, 0.f};
    bf16x8 At[4][2], B0[2][2], B1[2][2];
#define PG8_PM(u) ((u).pm & 0xffff)
#define PG8_PN(u) ((u).pn & 0xffff)
#define PG8_NT(u) ((u).pm >> 16)
#define PG8_KB(u) ((size_t)((((u).pn >> 16) & 0xff) * ((u).pm >> 16)) * (BK * 2))
    const char* cA = (const char*)g.A + (size_t)PG8_PM(cur) * tstep + PG8_KB(cur); const char* cB = (const char*)g.Bt + (size_t)PG8_PN(cur) * tstep + PG8_KB(cur);
    S.a_ready(cur);
    if constexpr (SP2) {
        PG8_STAGE(PG8_SB(0, 0), cB, voffB); PG8_STAGE(PG8_SB(0, 1), cB + hstep, voffB); PG8_STAGE(PG8_SA(0, 0), cA, voffA); PG8_STAGE(PG8_SA(0, 1), cA + hstep, voffA);
        if (wr == 1) PG8_BAR;
        PG8_WAIT_V(2); PG8_BAR;
        PG8_STAGE(PG8_SB(1, 0), cB + kstep, voffB); PG8_STAGE(PG8_SA(1, 0), cA + kstep, voffA); PG8_STAGE(PG8_SB(1, 1), cB + hstep + kstep, voffB);
        PG8_WAIT_V(6); PG8_BAR;
    } else {
        PG8_STAGE(PG8_SB(0, 0), cB, voffB); PG8_STAGE(PG8_SA(0, 0), cA, voffA); PG8_STAGE(PG8_SB(0, 1), cB + hstep, voffB); PG8_STAGE(PG8_SA(0, 1), cA + hstep, voffA);
        if (wr == 1) PG8_BAR;
        PG8_WAIT_V(4); PG8_BAR;
        PG8_STAGE(PG8_SB(1, 0), cB + kstep, voffB); PG8_STAGE(PG8_SA(1, 0), cA + kstep, voffA); PG8_STAGE(PG8_SB(1, 1), cB + hstep + kstep, voffB);
        PG8_WAIT_V(6); PG8_BAR;
    }
    for (;;) {
        const bool has_next = S.next(ui + 1, nxt);
        const char* nA = has_next ? (const char*)g.A + (size_t)PG8_PM(nxt) * tstep + PG8_KB(nxt) : cA; const char* nB = has_next ? (const char*)g.Bt + (size_t)PG8_PN(nxt) * tstep + PG8_KB(nxt) : cB;
        const int nt = PG8_NT(cur);
        for (int t = 0; t < nt; t += 2) {
            const bool last = (t == nt - 2);
            const char* a1 = cA + (size_t)(t + 1) * kstep;
            const char* a2 = last ? nA : cA + (size_t)(t + 2) * kstep; const char* b2 = last ? nB : cB + (size_t)(t + 2) * kstep;
            const char* a3 = a2 + kstep; const char* b3 = b2 + kstep;
            if (last && has_next) S.a_ready(nxt);
            if constexpr (SP2) {
            PG8_LDB(B0, 0, 0); PG8_LDB(B1, 0, 1); PG8_SCHED; PG8_LDA(At, 0, 0); PG8_STAGE(PG8_SA(1, 1), a1 + hstep, voffA);
            PG8_WAIT_V(8); PG8_WAIT_L(0); PG8_BAR; PG8_MMA(0, 0, At, B0); PG8_MMA(0, 1, At, B1); PG8_BAR; PG8_SCHED;
            PG8_LDA(At, 0, 1); PG8_STAGE(PG8_SB(0, 0), b2, voffB); PG8_STAGE(PG8_SB(0, 1), b2 + hstep, voffB); PG8_STAGE(PG8_SA(0, 0), a2, voffA);
            PG8_WAIT_V(8); PG8_WAIT_L(0); PG8_BAR; PG8_MMA(1, 0, At, B0); PG8_MMA(1, 1, At, B1); PG8_BAR; PG8_SCHED;
            PG8_LDB(B0, 1, 0); PG8_LDB(B1, 1, 1); PG8_SCHED; PG8_LDA(At, 1, 0); PG8_STAGE(PG8_SA(0, 1), a2 + hstep, voffA);
            PG8_WAIT_V(8); PG8_WAIT_L(0); PG8_BAR; PG8_MMA(0, 0, At, B0); PG8_MMA(0, 1, At, B1); PG8_BAR; PG8_SCHED;
            PG8_LDA(At, 1, 1); PG8_STAGE(PG8_SB(1, 0), b3, voffB); PG8_STAGE(PG8_SB(1, 1), b3 + hstep, voffB); PG8_STAGE(PG8_SA(1, 0), a3, voffA);
            PG8_WAIT_V(8); PG8_WAIT_L(0); PG8_BAR; PG8_MMA(1, 0, At, B0); PG8_MMA(1, 1, At, B1); PG8_BAR; PG8_SCHED;
            } else {
            PG8_LDB(B0, 0, 0); PG8_SCHED; PG8_LDA(At, 0, 0); PG8_STAGE(PG8_SA(1, 1), a1 + hstep, voffA);
            PG8_WAIT_L(8); PG8_BAR; PG8_WAIT_L(0); PG8_MMA(0, 0, At, B0); PG8_BAR; PG8_SCHED;
            PG8_LDB(B1, 0, 1); PG8_STAGE(PG8_SB(0, 0), b2, voffB);
            PG8_BAR; PG8_WAIT_L(0); PG8_MMA(0, 1, At, B1); PG8_BAR;
            PG8_LDA(At, 0, 1); PG8_STAGE(PG8_SA(0, 0), a2, voffA);
            PG8_BAR; PG8_WAIT_L(0); PG8_MMA(1, 0, At, B0); PG8_BAR; PG8_SCHED;
            PG8_STAGE(PG8_SB(0, 1), b2 + hstep, voffB);
            PG8_WAIT_V(6); PG8_BAR; PG8_MMA(1, 1, At, B1); PG8_BAR;
            PG8_LDB(B0, 1, 0); PG8_SCHED; PG8_LDA(At, 1, 0); PG8_STAGE(PG8_SA(0, 1), a2 + hstep, voffA);
            PG8_WAIT_L(8); PG8_BAR; PG8_WAIT_L(0); PG8_MMA(0, 0, At, B0); PG8_BAR; PG8_SCHED;
            PG8_LDB(B1, 1, 1); PG8_STAGE(PG8_SB(1, 0), b3, voffB);
            PG8_BAR; PG8_WAIT_L(0); PG8_MMA(0, 1, At, B1); PG8_BAR;
            PG8_LDA(At, 1, 1); PG8_STAGE(PG8_SA(1, 0), a3, voffA);
            PG8_BAR; PG8_WAIT_L(0); PG8_MMA(1, 0, At, B0); PG8_BAR; PG8_SCHED;
            PG8_STAGE(PG8_SB(1, 1), b3 + hstep, voffB);
            PG8_WAIT_V(6); PG8_BAR; PG8_MMA(1, 1, At, B1); PG8_BAR;
            }
        }
        if constexpr (ALIGN_EPI) { if (wr == 0) PG8_BAR; }
        if constexpr (!Epi::AFTER_DRAIN) { E(acc, cur, wr, wc, fr, fq); S.done(cur); }
        if (!has_next) break;
#pragma unroll
        for (int a = 0; a < 2; ++a)
#pragma unroll
            for (int b = 0; b < 2; ++b)
#pragma unroll
                for (int m = 0; m < 4; ++m)
#pragma unroll
                    for (int n = 0; n < 2; ++n) acc[a][b][m][n] = (f32x4){0.f, 0.f, 0.f, 0.f};
        cur = nxt; cA = nA; cB = nB; ++ui;
        if constexpr (ALIGN_EPI) { if (wr == 1) PG8_BAR; }
    }
    PG8_WAIT_V(0);
    if constexpr (!ALIGN_EPI) { if (wr == 0) PG8_BAR; }
    PG8_BAR;
    if constexpr (Epi::AFTER_DRAIN) { E.fused(acc, cur, wr, wc, fr, fq, lds, wid, lane); S.done(cur); }
#undef PG8_SA
#undef PG8_SB
#undef PG8_STAGE
#undef PG8_LDA
#undef PG8_LDB
#undef PG8_MMA
#undef PG8_WAIT_V
#undef PG8_WAIT_L
#undef PG8_BAR
#undef PG8_SCHED
}
}

#define LAS __attribute__((address_space(3)))
typedef unsigned short bf16_t;
typedef short bf16x8 __attribute__((ext_vector_type(8)));
typedef float f32x4 __attribute__((ext_vector_type(4)));
typedef float f32x16 __attribute__((ext_vector_type(16)));
typedef unsigned u32x4 __attribute__((ext_vector_type(4)));
typedef unsigned u32x2 __attribute__((ext_vector_type(2)));

constexpr int NB = 4, T = 8192, C = 256, P = T + C, D = 1024, DFF = 2816, INW = 1952, DEPTH = 4;
constexpr int MLAT = NB * T, MTOT = MLAT + NB * C;
constexpr int NWAVES = 8, NTHR = 512;
constexpr float EPS = 1e-6f, LOG2E = 1.4426950408889634f;
constexpr int NCHUNK = P / 32;
constexpr int Z_LX = 0, Z_LG = 384, Z_CQ = 768, Z_CKV = 1024, Z_KR = 1152, Z_NQ = 1184, Z_NK = 1440, Z_NV = 1696;

constexpr size_t MiB = 1u << 20;
constexpr size_t OFF_MOD = 0;
constexpr size_t OFF_ROPE = 1 * MiB;
constexpr size_t OFF_BAR = 1 * MiB + 65536;
constexpr size_t OFF_LRUS = 2 * MiB;
constexpr size_t OFF_LRUC = 9 * MiB;
constexpr size_t OFF_HC = 13 * MiB;
constexpr size_t OFF_W = 18 * MiB;
constexpr size_t W_FFN1_IN = 0, W_FFN1_OUT = W_FFN1_IN + (size_t)5632 * 1024 * 2, W_FFN2_IN = W_FFN1_OUT + (size_t)1024 * 2816 * 2,
                 W_FFN2_OUT = W_FFN2_IN + (size_t)5632 * 1024 * 2, W_IN = W_FFN2_OUT + (size_t)1024 * 2816 * 2, W_OUT = W_IN + (size_t)2048 * 1024 * 2,
                 W_UQ = W_OUT + (size_t)1024 * 1024 * 2, W_UKV = W_UQ + (size_t)768 * 256 * 2, W_LRU = W_UKV + (size_t)768 * 256 * 2, W_END = W_LRU + (size_t)24 * 64 * 64 * 2;
static_assert(W_END <= 42 * MiB, "weights");
constexpr size_t OFF_XN = 60 * MiB;
constexpr size_t OFF_BIG = 126 * MiB;
constexpr size_t OFF_HFF = OFF_BIG;
constexpr size_t OFF_Z = OFF_BIG;
constexpr size_t OFF_CQN = OFF_Z + (size_t)MTOT * INW * 2;
constexpr size_t OFF_CKVN = OFF_CQN + (size_t)MTOT * 256 * 2;
constexpr size_t OFF_QRAW = OFF_CKVN + (size_t)MTOT * 256 * 2;
constexpr size_t OFF_KVRAW = OFF_QRAW + (size_t)MTOT * 576 * 2;
constexpr size_t OFF_QM = OFF_KVRAW + (size_t)MTOT * 768 * 2;
constexpr size_t OFF_KM = OFF_QM + (size_t)NB * 6 * P * 96 * 2;
constexpr size_t OFF_VMT = OFF_KM + (size_t)NB * 6 * P * 96 * 2;
constexpr size_t OFF_NQ = OFF_VMT + (size_t)NB * 6 * 64 * P * 2;
constexpr size_t OFF_NK = OFF_NQ + (size_t)NB * 4 * P * 64 * 2;
constexpr size_t OFF_NVT = OFF_NK + (size_t)NB * 4 * P * 64 * 2;
constexpr size_t WS_END = OFF_NVT + (size_t)NB * 4 * 64 * P * 2;
constexpr size_t OFF_PART = WS_END;
constexpr size_t WS_END2 = OFF_PART + (size_t)11 * 1024 * 1024 * 4;
static_assert(OFF_XN + (size_t)MTOT * 1024 * 2 <= OFF_BIG && OFF_HFF + (size_t)MTOT * DFF * 2 <= WS_END, "ws map");

constexpr int LDS_BYTES = 147456;

using pg8::f16x8; using pg8::f16x2;
__device__ __forceinline__ unsigned f2bf(float f) { return (unsigned)__builtin_bit_cast(unsigned short, (_Float16)f); }
__device__ __forceinline__ unsigned pk2(float lo, float hi) { return pg8::cvt_pk_bf16(lo, hi); }
__device__ __forceinline__ float bflo(unsigned u) { return (float)__builtin_bit_cast(f16x2, u).x; }
__device__ __forceinline__ float bfhi(unsigned u) { return (float)__builtin_bit_cast(f16x2, u).y; }
__device__ __forceinline__ float bf2f(bf16_t x) { return (float)__builtin_bit_cast(_Float16, x); }
#define MFMA32(a, b, c) __builtin_amdgcn_mfma_f32_32x32x16_f16(__builtin_bit_cast(f16x8, (a)), __builtin_bit_cast(f16x8, (b)), (c), 0, 0, 0)
template <int O> __device__ __forceinline__ float swz_xor(float x) { return __builtin_bit_cast(float, __builtin_amdgcn_ds_swizzle(__builtin_bit_cast(int, x), (O << 10) | 0x1f)); }
__device__ __forceinline__ float xhalf(float x) {
    const unsigned xb = __builtin_bit_cast(unsigned, x); auto t = __builtin_amdgcn_permlane32_swap(xb, xb, false, false);
    return __builtin_bit_cast(float, t[0] == xb ? t[1] : t[0]); }
__device__ __forceinline__ float xhalf_sum(float x) { const unsigned xb = __builtin_bit_cast(unsigned, x); auto t = __builtin_amdgcn_permlane32_swap(xb, xb, false, false);
    return __builtin_bit_cast(float, (unsigned)t[0]) + __builtin_bit_cast(float, (unsigned)t[1]); }
__device__ __forceinline__ float xhalf_max(float x) { const unsigned xb = __builtin_bit_cast(unsigned, x); auto t = __builtin_amdgcn_permlane32_swap(xb, xb, false, false);
    return fmaxf(__builtin_bit_cast(float, (unsigned)t[0]), __builtin_bit_cast(float, (unsigned)t[1])); }
template <int CTRL> __device__ __forceinline__ float dppf(float x) { return __builtin_bit_cast(float, __builtin_amdgcn_mov_dpp(__builtin_bit_cast(int, x), CTRL, 0xf, 0xf, true)); }
__device__ __forceinline__ float row16_sum(float v) { v += dppf<0xB1>(v); v += dppf<0x4E>(v); v += dppf<0x141>(v); v += dppf<0x140>(v); return v; }
__device__ __forceinline__ float wave_sum(float v) {
    v = row16_sum(v);
    { const unsigned xb = __builtin_bit_cast(unsigned, v); auto t = __builtin_amdgcn_permlane16_swap(xb, xb, false, false); v = __builtin_bit_cast(float, (unsigned)t[0]) + __builtin_bit_cast(float, (unsigned)t[1]); }
    return xhalf_sum(v);
}
__device__ __forceinline__ float sigmoidf_(float x) { return __builtin_amdgcn_rcpf(1.f + __expf(-x)); }
__device__ __forceinline__ int clampi(int v, int lo, int hi) { return v < lo ? lo : (v > hi ? hi : v); }
#define LDS_WAIT() asm volatile("s_waitcnt lgkmcnt(0)" ::: "memory")

struct EpiStore {
    static constexpr bool PERM = true, AFTER_DRAIN = false;
    bf16_t* O; int ldc; int ncols;
    __device__ __forceinline__ void operator()(const pg8::f32x4 (&acc)[2][2][4][2], const pg8::Unit& uu, int wr, int wc, int fr, int fq) const {
        asm volatile("" : "+v"(fr), "+v"(fq));
        const int upm = uu.pm & 0xffff, upn = uu.pn & 0xffff, unt = uu.pm >> 16; (void)unt;
        const int row0 = upm * 256 + wr * 64 + fr, col0 = upn * 256 + wc * 32 + 8 * fq;
#pragma unroll
        for (int ai = 0; ai < 2; ++ai)
#pragma unroll
            for (int m = 0; m < 4; ++m) { bf16_t* rowp = O + (size_t)(row0 + ai * 128 + m * 16) * ldc;
#pragma unroll
                for (int bj = 0; bj < 2; ++bj) { const int col = col0 + bj * 128;
                    if (col < ncols) { const pg8::f32x4 v0 = acc[ai][bj][m][0], v1 = acc[ai][bj][m][1];
                        u32x4 w; w.x = pg8::cvt_pk_bf16(v0[0], v0[1]); w.y = pg8::cvt_pk_bf16(v0[2], v0[3]); w.z = pg8::cvt_pk_bf16(v1[0], v1[1]); w.w = pg8::cvt_pk_bf16(v1[2], v1[3]);
                        *(u32x4*)(rowp + col) = w; } } }
    }
};
struct EpiSwiGLU {
    static constexpr bool PERM = true, AFTER_DRAIN = false;
    bf16_t* O;
    __device__ __forceinline__ void operator()(const pg8::f32x4 (&acc)[2][2][4][2], const pg8::Unit& uu, int wr, int wc, int fr, int fq) const {
        asm volatile("" : "+v"(fr), "+v"(fq));
        const int upm = uu.pm & 0xffff, upn = uu.pn & 0xffff, unt = uu.pm >> 16; (void)unt;
        const int row0 = upm * 256 + wr * 64 + fr, col = upn * 128 + wc * 32 + 8 * fq;
#pragma unroll
        for (int ai = 0; ai < 2; ++ai)
#pragma unroll
            for (int m = 0; m < 4; ++m) { float o[8];
#pragma unroll
                for (int n = 0; n < 2; ++n)
#pragma unroll
                    for (int e = 0; e < 4; ++e) { const float g = acc[ai][0][m][n][e], up = acc[ai][1][m][n][e]; o[4 * n + e] = g * sigmoidf_(g) * up; }
                u32x4 w; w.x = pg8::cvt_pk_bf16(o[0], o[1]); w.y = pg8::cvt_pk_bf16(o[2], o[3]); w.z = pg8::cvt_pk_bf16(o[4], o[5]); w.w = pg8::cvt_pk_bf16(o[6], o[7]);
                *(u32x4*)(O + (size_t)(row0 + ai * 128 + m * 16) * DFF + col) = w; }
    }
};
struct EpiResid {
    static constexpr bool PERM = true, AFTER_DRAIN = false;
    float* hl; float* hc; const float* gate; float coef;
    __device__ __forceinline__ void operator()(const pg8::f32x4 (&acc)[2][2][4][2], const pg8::Unit& uu, int wr, int wc, int fr, int fq) const {
        asm volatile("" : "+v"(fr), "+v"(fq));
        const int upm = uu.pm & 0xffff, upn = uu.pn & 0xffff, unt = uu.pm >> 16; (void)unt;
        float* base; const float* g;
        if (upm < 128) { base = hl + (size_t)upm * 256 * D; g = gate + (upm >> 5) * 9216; } else { base = hc + (size_t)(upm - 128) * 256 * D; g = gate + 4 * 9216; }
        const int col0 = upn * 256 + wc * 32 + 8 * fq;
        pg8::f32x4 gv[2][2];
#pragma unroll
        for (int bj = 0; bj < 2; ++bj)
#pragma unroll
            for (int n = 0; n < 2; ++n) gv[bj][n] = *(const pg8::f32x4*)(g + col0 + bj * 128 + 4 * n) * coef;
        if (!((uu.pn >> 30) & 1)) {
#pragma unroll
            for (int ai = 0; ai < 2; ++ai)
#pragma unroll
                for (int m = 0; m < 4; ++m) { float* rowp = base + (size_t)(wr * 64 + fr + ai * 128 + m * 16) * D + col0;
#pragma unroll
                    for (int bj = 0; bj < 2; ++bj)
#pragma unroll
                        for (int n = 0; n < 2; ++n) { pg8::f32x4* p = (pg8::f32x4*)(rowp + bj * 128 + 4 * n); *p = *p + gv[bj][n] * acc[ai][bj][m][n]; } }
        } else {
            float* pb = hc + (OFF_PART - OFF_HC) / 4 + ((size_t)((uu.pn >> 16) & 0xff) * 1024 + (size_t)(upm - 128) * 256) * D;
#pragma unroll
            for (int ai = 0; ai < 2; ++ai)
#pragma unroll
                for (int m = 0; m < 4; ++m) { float* rowp = pb + (size_t)(wr * 64 + fr + ai * 128 + m * 16) * D + col0;
#pragma unroll
                    for (int bj = 0; bj < 2; ++bj)
#pragma unroll
                        for (int n = 0; n < 2; ++n) *(pg8::f32x4*)(rowp + bj * 128 + 4 * n) = gv[bj][n] * acc[ai][bj][m][n]; }
        }
    }
};

struct CtxOrder {
    int n_lat, n_ctx, nN, ksplit, ntfull, G, c;
    __device__ __forceinline__ void init(int N, int K, int G_, int c_, int nctx_panels, int ksplit_) { nN = N / 256; n_lat = 128 * nN; ksplit = ksplit_; ntfull = K / 64; n_ctx = nctx_panels * nN * ksplit_; G = G_; c = c_; }
    __device__ __forceinline__ bool next(int i, pg8::Unit& u) const {
        const int L = i * G + c;
        if (L < n_lat) {
            const int wgid = (L & 7) * (n_lat >> 3) + (L >> 3), nig = 8 * nN, w = wgid % nig;
            u.pm = ((wgid / nig) * 8 + (w & 7)) | (ntfull << 16); u.pn = w >> 3; return true; }
        const int q = L - n_lat; if (q >= n_ctx) return false;
        const int ks = q % ksplit, rest = q / ksplit; u.pn = (rest % nN) | (ks << 16) | (ksplit > 1 ? (1 << 30) : 0); u.pm = (128 + rest / nN) | ((ntfull / ksplit) << 16); return true;
    }
    __device__ __forceinline__ void a_ready(const pg8::Unit&) const {}
    __device__ __forceinline__ void done(const pg8::Unit&) const {}
};

template <int MODE> __device__ __forceinline__ int dest_row(int n0) {
    if (MODE == 1) { const int g = n0 >= DFF ? 1 : 0; const int nn = n0 - g * DFF; return (nn >> 7) * 256 + g * 128 + (nn & 127); }
    return n0;
}
template <int MODE> __device__ __forceinline__ void transpose_item(const float* __restrict__ W, int N, bf16_t* __restrict__ WT, int ldk, LAS float* scr, int item, int lane) {
    const int nblk = N / 32, kb = item / nblk, nb = item % nblk, k0 = 64 * kb, n0 = 32 * nb;
#pragma unroll 8
    for (int i = 0; i < 32; ++i) { const int kk = 2 * i + (lane >> 5); scr[kk * 33 + (lane & 31)] = W[(size_t)(k0 + kk) * N + n0 + (lane & 31)]; }
    LDS_WAIT();
    const int c = lane & 7, r0 = dest_row<MODE>(n0);
#pragma unroll
    for (int j = 0; j < 4; ++j) { const int n = (lane >> 3) + 8 * j; const LAS float* s = scr + (8 * c) * 33 + n;
        u32x4 o; o.x = pk2(s[0 * 33], s[1 * 33]); o.y = pk2(s[2 * 33], s[3 * 33]); o.z = pk2(s[4 * 33], s[5 * 33]); o.w = pk2(s[6 * 33], s[7 * 33]);
        *(u32x4*)(WT + (size_t)(r0 + n) * ldk + k0 + 8 * c) = o; }
    LDS_WAIT();
}

struct Args { const float* in[31]; float* out; unsigned char* ws; int ph_lo, ph_hi; };
typedef const __attribute__((address_space(4))) Args* ArgP;

__device__ __forceinline__ void convert_weights(ArgP a, int l, LAS unsigned char* lds, int gw, int NGW, int wave, int lane) {
    unsigned char* wb = a->ws + OFF_W;
    LAS float* scr = (LAS float*)(lds + wave * 16384);
    constexpr int I_FI = 16 * 176, I_FO = 44 * 32, I_WI = 16 * 61, I_WO = 16 * 32, I_UQ = 4 * 18, I_UKV = 2 * 24, I_LRU = 48;
    constexpr int NIT = 2 * I_FI + 2 * I_FO + I_WI + I_WO + I_UQ + I_UKV + I_LRU;
    for (int it = gw; it < NIT; it += NGW) {
        int r = it;
        if (r < I_FI) { transpose_item<1>(a->in[7] + (size_t)l * D * 2 * DFF, 2 * DFF, (bf16_t*)(wb + W_FFN1_IN), D, scr, r, lane); continue; } r -= I_FI;
        if (r < I_FI) { transpose_item<1>(a->in[29] + (size_t)l * D * 2 * DFF, 2 * DFF, (bf16_t*)(wb + W_FFN2_IN), D, scr, r, lane); continue; } r -= I_FI;
        if (r < I_FO) { transpose_item<0>(a->in[8] + (size_t)l * DFF * D, D, (bf16_t*)(wb + W_FFN1_OUT), DFF, scr, r, lane); continue; } r -= I_FO;
        if (r < I_FO) { transpose_item<0>(a->in[30] + (size_t)l * DFF * D, D, (bf16_t*)(wb + W_FFN2_OUT), DFF, scr, r, lane); continue; } r -= I_FO;
        if (r < I_WI) { transpose_item<0>(a->in[10] + (size_t)l * D * INW, INW, (bf16_t*)(wb + W_IN), D, scr, r, lane); continue; } r -= I_WI;
        if (r < I_WO) { transpose_item<0>(a->in[11] + (size_t)l * D * D, D, (bf16_t*)(wb + W_OUT), D, scr, r, lane); continue; } r -= I_WO;
        if (r < I_UQ) { transpose_item<0>(a->in[20] + (size_t)l * 256 * 576, 576, (bf16_t*)(wb + W_UQ), 256, scr, r, lane); continue; } r -= I_UQ;
        if (r < I_UKV) { transpose_item<0>(a->in[22] + (size_t)l * 128 * 768, 768, (bf16_t*)(wb + W_UKV), 256, scr, r, lane); continue; } r -= I_UKV;
        { const int mat = r >> 1, sub = r & 1, ax = (mat / 6) & 1, dir = mat / 12, n = mat % 6;
          const float* src = (ax ? a->in[16] : a->in[14]) + (size_t)((l * 2 + dir) * 6 + n) * 4096;
          transpose_item<0>(src, 64, (bf16_t*)(wb + W_LRU) + (size_t)mat * 4096, 64, scr, sub, lane); }
    }
    const int gt = gw * 64 + lane, GT = NGW * 64; unsigned zz = 0u; asm volatile("" : "+v"(zz)); const u32x4 z = {zz, zz, zz, zz};
    for (int i = gt; i < 12288; i += GT) *(u32x4*)(wb + W_IN + (size_t)1952 * 1024 * 2 + (size_t)i * 16) = z;
    for (int i = gt; i < 6144; i += GT) *(u32x4*)(wb + W_UQ + (size_t)576 * 256 * 2 + (size_t)i * 16) = z;
    for (int i = gt; i < 12288; i += GT) *(u32x4*)(wb + W_UKV + (size_t)(i >> 4) * 512 + 256 + (i & 15) * 16) = z;
}

__device__ __forceinline__ void p0_phase(ArgP a, LAS unsigned char* lds, int tid, int wave, int lane, int bid, int G) {
    const int gt = bid * NTHR + tid, GT = G * NTHR;
    { const f32x4* xs = (const f32x4*)a->in[0]; f32x4* xd = (f32x4*)a->out;
      for (int i = gt; i < MLAT * D / 4; i += GT) xd[i] = xs[i];
      const f32x4* cs = (const f32x4*)a->in[2]; f32x4* cd = (f32x4*)(a->ws + OFF_HC);
      for (int i = gt; i < NB * C * D / 4; i += GT) cd[i] = cs[i]; }
    if (bid == 0) {
        float* rope = (float*)(a->ws + OFF_ROPE);
        for (int i = tid; i < 1024; i += NTHR) { const int pos = i >> 3, j = i & 7;
            const float invs[8] = {1.0f, 0.31622776f, 0.1f, 0.031622775f, 0.01f, 0.0031622776f, 0.001f, 0.00031622776f};
            float inv = invs[0];
#pragma unroll
            for (int q = 1; q < 8; ++q) inv = (j == q) ? invs[q] : inv;
            const float x = (float)pos * inv;
            const float q = rintf(x * 0.63661977236758134f); const int n = (int)q;
            float rr = fmaf(-q, 1.5703125f, x); rr = fmaf(-q, 4.837512969970703125e-4f, rr); rr = fmaf(-q, 7.54978995489188216e-8f, rr);
            const float r2 = rr * rr;
            const float sr = rr + rr * r2 * (-1.6666654611e-1f + r2 * (8.3321608736e-3f + r2 * (-1.9515295891e-4f)));
            const float cr = 1.0f - 0.5f * r2 + r2 * r2 * (4.166664568298827e-2f + r2 * (-1.388731625493765e-3f + r2 * (2.443315711809948e-5f)));
            float s, c; const int qd = n & 3;
            if (qd == 0) { s = sr; c = cr; } else if (qd == 1) { s = cr; c = -sr; } else if (qd == 2) { s = -sr; c = -cr; } else { s = -cr; c = sr; }
            rope[2 * i] = c; rope[2 * i + 1] = s; }
    }
    LAS float* sl = (LAS float*)lds; LAS float* red = (LAS float*)(lds + 5 * 1024 * 4);
    for (int i = tid; i < 5 * 1024; i += NTHR) { const int mi = i >> 10, k = i & 1023; const float v = mi < 4 ? a->in[1][mi * 1024 + k] : a->in[3][k]; sl[i] = v * sigmoidf_(v); }
    __syncthreads();
    float* MOD = (float*)(a->ws + OFF_MOD);
    for (int item = bid; item < 576; item += G) {
        const int l = item / 144, n0 = (item % 144) * 64;
        const float* wp = a->in[4] + (size_t)l * 1024 * 9216 + n0 + lane;
        float ac[5] = {0.f, 0.f, 0.f, 0.f, 0.f};
#pragma unroll 8
        for (int kk = 0; kk < 128; ++kk) { const int k = wave * 128 + kk; const float wv = wp[(size_t)k * 9216];
#pragma unroll
            for (int mi = 0; mi < 5; ++mi) ac[mi] += sl[mi * 1024 + k] * wv; }
#pragma unroll
        for (int mi = 0; mi < 5; ++mi) red[(wave * 5 + mi) * 64 + lane] = ac[mi];
        __syncthreads();
        if (tid < 320) { const int mi = tid >> 6; float s = 0.f;
#pragma unroll
            for (int w = 0; w < 8; ++w) s += red[(w * 5 + mi) * 64 + lane];
            MOD[(size_t)(l * 5 + mi) * 9216 + n0 + lane] = s + a->in[5][l * 9216 + n0 + lane]; }
        __syncthreads();
    }
}

__device__ __forceinline__ void norm_phase(const float* hl, const float* hc, const float* __restrict__ g, const float* __restrict__ modl, int sh_chunk, bf16_t* XN, int gw, int NGW, int lane, int nrows, const float* part, int npieces) {
    for (int rr = gw; rr < nrows; rr += NGW) {
        const int row = nrows - 1 - rr;
        const float* xr = row < MLAT ? hl + (size_t)row * D : hc + (size_t)(row - MLAT) * D;
        const int mi = row < MLAT ? (row >> 13) : 4;
        const float* shift = modl + mi * 9216 + sh_chunk * 1024; const float* scale = shift + 1024;
        f32x4 v[4]; float s = 0.f;
#pragma unroll
        for (int j = 0; j < 4; ++j) v[j] = *(const f32x4*)(xr + 4 * lane + 256 * j);
        if (row >= MLAT && npieces > 0) {
            for (int p = 0; p < npieces; ++p) { const float* pr = part + ((size_t)p * 1024 + (row - MLAT)) * D + 4 * lane;
#pragma unroll
                for (int j = 0; j < 4; ++j) v[j] = v[j] + *(const f32x4*)(pr + 256 * j); }
#pragma unroll
            for (int j = 0; j < 4; ++j) *(f32x4*)(const_cast<float*>(xr) + 4 * lane + 256 * j) = v[j];
        }
#pragma unroll
        for (int j = 0; j < 4; ++j) s += (v[j].x * v[j].x + v[j].y * v[j].y) + (v[j].z * v[j].z + v[j].w * v[j].w);
        const float rstd = 1.f / sqrtf(wave_sum(s) * (1.f / D) + EPS);
#pragma unroll
        for (int j = 0; j < 4; ++j) { const int k = 4 * lane + 256 * j;
            const f32x4 gg = *(const f32x4*)(g + k), sc = *(const f32x4*)(scale + k), sh = *(const f32x4*)(shift + k);
            const f32x4 y = (v[j] * rstd) * gg * (sc + 1.f) + sh;
            u32x2 o; o.x = pk2(y.x, y.y); o.y = pk2(y.z, y.w);
            *(u32x2*)(XN + (size_t)row * D + k) = o; }
    }
}

struct TileGeo { int R0, b, p0, s0, seglen, latent; };
__device__ __forceinline__ TileGeo tile_geo(int tl) {
    TileGeo g; g.R0 = tl * 64; g.latent = tl < 512;
    if (g.latent) { g.b = tl >> 7; g.s0 = (tl & 127) * 64; g.p0 = 256 + g.s0; g.seglen = T; }
    else { g.b = (tl - 512) >> 2; g.s0 = ((tl - 512) & 3) * 64; g.p0 = g.s0; g.seglen = C; }
    return g;
}

constexpr int XC_STR = 388;
__device__ __forceinline__ void lru_conv_tile(ArgP a, int l, const TileGeo& g, LAS float* xc, int tid) {
    if (tid < 384) {
        const bf16_t* Z = (const bf16_t*)(a->ws + OFF_Z) + (size_t)g.R0 * INW + Z_LX + tid;
        const float* cw = a->in[12] + (size_t)l * 4 * 384 + tid;
        const float w0 = cw[0], w1 = cw[384], w2 = cw[768], w3 = cw[1152], cb = a->in[13][l * 384 + tid];
        float xm2 = (g.s0 - 2 >= 0) ? bf2f(Z[(ptrdiff_t)(-2) * INW]) : 0.f;
        float xm1 = (g.s0 - 1 >= 0) ? bf2f(Z[(ptrdiff_t)(-1) * INW]) : 0.f;
        float x0 = bf2f(Z[0]);
        for (int i0 = 0; i0 < 64; i0 += 16) {
            float xn[16];
#pragma unroll
            for (int k = 0; k < 16; ++k) xn[k] = (g.s0 + i0 + k + 1 < g.seglen) ? bf2f(Z[(ptrdiff_t)(i0 + k + 1) * INW]) : 0.f;
#pragma unroll
            for (int k = 0; k < 16; ++k) { xc[(i0 + k) * XC_STR + tid] = cb + w0 * xm2 + w1 * xm1 + w2 * x0 + w3 * xn[k]; xm2 = xm1; xm1 = x0; x0 = xn[k]; }
        }
    }
}
template <bool FINAL>
__device__ __forceinline__ void lru_tasks(ArgP a, int l, const TileGeo& g, const LAS float* xc, int wave, int lane) {
    const int r = lane & 31, h = lane >> 5;
    const bf16_t* WL = (const bf16_t*)(a->ws + OFF_W + W_LRU);
    const float2* SUMS = (const float2*)(a->ws + OFF_LRUS); const float* CARRY = (const float*)(a->ws + OFF_LRUC);
    for (int task = wave; task < 24; task += NWAVES) {
        const int sub = task / 12, cgp = task % 12, n = cgp >> 1, chalf = cgp & 1;
        const int ch = 32 * cgp + r;
        const int chunk = (g.p0 >> 5) + sub;
        bf16x8 af[4];
#pragma unroll
        for (int ks = 0; ks < 4; ++ks) { const LAS float* xp = xc + (32 * sub + r) * XC_STR + 64 * n + 16 * ks + 8 * h;
            const f32x4 v0 = *(const LAS f32x4*)xp, v1 = *(const LAS f32x4*)(xp + 4);
            u32x4 w; w.x = pk2(v0.x, v0.y); w.y = pk2(v0.z, v0.w); w.z = pk2(v1.x, v1.y); w.w = pk2(v1.z, v1.w); af[ks] = __builtin_bit_cast(bf16x8, w); }
        float xv[16];
#pragma unroll
        for (int v = 0; v < 16; ++v) xv[v] = xc[(32 * sub + (v & 3) + 8 * (v >> 2) + 4 * h) * XC_STR + ch];
        float y[16];
#pragma unroll
        for (int v = 0; v < 16; ++v) y[v] = 0.f;
#pragma unroll
        for (int dir = 0; dir < 2; ++dir) {
            f32x16 pa, px;
#pragma unroll
            for (int v = 0; v < 16; ++v) { pa[v] = 0.f; px[v] = 0.f; }
            const bf16_t* wa = WL + (size_t)((dir * 2 + 0) * 6 + n) * 4096 + (32 * chalf + r) * 64 + 8 * h;
            const bf16_t* wx = WL + (size_t)((dir * 2 + 1) * 6 + n) * 4096 + (32 * chalf + r) * 64 + 8 * h;
#pragma unroll
            for (int ks = 0; ks < 4; ++ks) { const bf16x8 ba = *(const bf16x8*)(wa + 16 * ks), bx = *(const bf16x8*)(wx + 16 * ks);
                pa = MFMA32(af[ks], ba, pa); px = MFMA32(af[ks], bx, px); }
            const float ba_ = a->in[15][(l * 2 + dir) * 384 + ch], bx_ = a->in[17][(l * 2 + dir) * 384 + ch], lam = a->in[18][(l * 2 + dir) * 384 + ch];
            const float k1 = -8.0f * LOG2E * log1pf(__expf(-lam));
            float av[16], uv[16];
#pragma unroll
            for (int v = 0; v < 16; ++v) { const float rg = sigmoidf_(pa[v] + ba_), ig = sigmoidf_(px[v] + bx_);
                const float l2 = k1 * rg, aa = __builtin_amdgcn_exp2f(l2); av[v] = aa;
                const float x2 = l2 * 1.3862943611198906f;
                const float pl = x2 * (1.f + x2 * (0.5f + x2 * (0.16666667f + x2 * (0.041666668f + x2 * (0.0083333338f + x2 * 0.0013888889f)))));
                const float om = x2 > -0.25f ? -pl : fmaf(-aa, aa, 1.0f);
                uv[v] = __builtin_amdgcn_sqrtf(om) * (ig * xv[v]); }
            float GA[4], GU[4];
#pragma unroll
            for (int q = 0; q < 4; ++q) { float A = 1.f, U = 0.f;
#pragma unroll
                for (int cc = 0; cc < 4; ++cc) { const int c2 = dir == 0 ? cc : 3 - cc; const int v = 4 * q + c2; U = av[v] * U + uv[v]; A = av[v] * A; }
                GA[q] = A; GU[q] = U; }
            float OA[4], OU[4];
#pragma unroll
            for (int q = 0; q < 4; ++q) { OA[q] = xhalf(GA[q]); OU[q] = xhalf(GU[q]); }
            float LA[8], LU[8];
#pragma unroll
            for (int q = 0; q < 4; ++q) { LA[2 * q] = h == 0 ? GA[q] : OA[q]; LU[2 * q] = h == 0 ? GU[q] : OU[q]; LA[2 * q + 1] = h == 1 ? GA[q] : OA[q]; LU[2 * q + 1] = h == 1 ? GU[q] : OU[q]; }
            if (!FINAL) {
                float A = 1.f, U = 0.f;
#pragma unroll
                for (int gg = 0; gg < 8; ++gg) { const int gi = dir == 0 ? gg : 7 - gg; U = LA[gi] * U + LU[gi]; A = LA[gi] * A; }
                if (h == 0) { float2 o; o.x = A; o.y = U; ((float2*)SUMS)[(size_t)((g.b * 2 + dir) * NCHUNK + chunk) * 384 + ch] = o; }
            } else {
                float X = CARRY[(size_t)((g.b * 2 + dir) * NCHUNK + chunk) * 384 + ch];
                float XS[8];
#pragma unroll
                for (int gg = 0; gg < 8; ++gg) { const int gi = dir == 0 ? gg : 7 - gg; XS[gi] = X; X = LA[gi] * X + LU[gi]; }
#pragma unroll
                for (int q = 0; q < 4; ++q) { float x = h == 0 ? XS[2 * q] : XS[2 * q + 1];
#pragma unroll
                    for (int cc = 0; cc < 4; ++cc) { const int c2 = dir == 0 ? cc : 3 - cc; const int v = 4 * q + c2; x = av[v] * x + uv[v]; y[v] += x; } }
            }
        }
        if (FINAL) {
            const bf16_t* Z = (const bf16_t*)(a->ws + OFF_Z); bf16_t* Y = (bf16_t*)(a->ws + OFF_XN);
#pragma unroll
            for (int v = 0; v < 16; ++v) { const int row = g.R0 + 32 * sub + (v & 3) + 8 * (v >> 2) + 4 * h;
                const float lg = bf2f(Z[(size_t)row * INW + Z_LG + ch]);
                const float ge = lg * sigmoidf_(1.5957691216057308f * (lg + 0.044715f * lg * lg * lg));
                Y[(size_t)row * D + ch] = (bf16_t)f2bf(y[v] * ge); }
        }
    }
}
__device__ __forceinline__ void lru_carry(ArgP a, int item, int lane) {
    const int bd = item / 6, ch = 64 * (item % 6) + lane, dir = bd & 1;
    const float2* S = (const float2*)(a->ws + OFF_LRUS) + (size_t)bd * NCHUNK * 384 + ch; float* Cr = (float*)(a->ws + OFF_LRUC) + (size_t)bd * NCHUNK * 384 + ch;
    float X = 0.f;
    for (int i0 = 0; i0 < NCHUNK; i0 += 8) {
        float2 s[8]; int ck[8];
#pragma unroll
        for (int j = 0; j < 8; ++j) { const int i = i0 + j;
            ck[j] = dir == 0 ? i : (i < 8 ? 7 - i : NCHUNK + 7 - i); s[j] = S[(size_t)ck[j] * 384]; }
#pragma unroll
        for (int j = 0; j < 8; ++j) { Cr[(size_t)ck[j] * 384] = X; X = s[j].x * X + s[j].y; }
    }
}

constexpr int LRU_CW_OFF = 65536, LRU_T_OFF = 73728, LRU_T_STR = 65;
template <bool FINAL>
__device__ __forceinline__ void lru_wave_phase(ArgP a, int l, LAS unsigned char* lds, int gw, int NGW, int wave, int lane, int tid, int nchunks = 1056) {
    LAS float* cw = (LAS float*)(lds + LRU_CW_OFF);
    for (int i = tid; i < 5 * 384; i += NTHR) cw[i] = i < 1536 ? a->in[12][l * 1536 + i] : a->in[13][l * 384 + (i - 1536)];
    __syncthreads();
    const int NWG = NGW / 12;
    if (gw < NWG * 12) {
        const int g = gw % 12, n = g >> 1, chalf = g & 1, r = lane & 31, h = lane >> 5, ch = 32 * g + r;
        const bf16_t* WL = (const bf16_t*)(a->ws + OFF_W + W_LRU); const bf16_t* Z = (const bf16_t*)(a->ws + OFF_Z);
        bf16x8 wfa[2][4], wfx[2][4]; float ba_[2], bx_[2], k1[2];
#pragma unroll
        for (int dir = 0; dir < 2; ++dir) {
            const bf16_t* wa = WL + (size_t)((dir * 2 + 0) * 6 + n) * 4096 + (32 * chalf + r) * 64 + 8 * h; const bf16_t* wx = WL + (size_t)((dir * 2 + 1) * 6 + n) * 4096 + (32 * chalf + r) * 64 + 8 * h;
#pragma unroll
            for (int ks = 0; ks < 4; ++ks) { wfa[dir][ks] = *(const bf16x8*)(wa + 16 * ks); wfx[dir][ks] = *(const bf16x8*)(wx + 16 * ks); }
            ba_[dir] = a->in[15][(l * 2 + dir) * 384 + ch]; bx_[dir] = a->in[17][(l * 2 + dir) * 384 + ch];
            k1[dir] = -8.0f * LOG2E * log1pf(__expf(-a->in[18][(l * 2 + dir) * 384 + ch]));
        }
        LAS float* Tw = (LAS float*)(lds + LRU_T_OFF) + wave * (32 * LRU_T_STR);
        const LAS float* cwl = cw + 64 * n + 8 * h;
        for (int cid = gw / 12; cid < nchunks; cid += NWG) {
            int b, cs, R0, seglen, chunk;
            if (cid < 1024) { b = cid >> 8; cs = cid & 255; R0 = b * T + 32 * cs; seglen = T; chunk = 8 + cs; } else { const int q = cid - 1024; b = q >> 3; cs = q & 7; R0 = MLAT + b * C + 32 * cs; seglen = C; chunk = cs; }
            const int s0 = 32 * cs;
            bf16x8 af[4];
#pragma unroll
            for (int kp = 0; kp < 2; ++kp) {
                u32x4 ux[4][2];
#pragma unroll
                for (int t = 0; t < 4; ++t) { const int sp = s0 + r + t - 2; const bool ok = sp >= 0 && sp < seglen; const bf16_t* zr = Z + (ptrdiff_t)(R0 + r + t - 2) * INW + 64 * n + 8 * h + 32 * kp;
#pragma unroll
                    for (int k2 = 0; k2 < 2; ++k2) { u32x4 u = {0u, 0u, 0u, 0u}; if (ok) u = *(const u32x4*)(zr + 16 * k2); ux[t][k2] = u; } }
#pragma unroll
                for (int k2 = 0; k2 < 2; ++k2) { const int ks = 2 * kp + k2; float cv[8];
                    { const f32x4 b0 = *(const LAS f32x4*)(cwl + 1536 + 16 * ks), b1 = *(const LAS f32x4*)(cwl + 1536 + 16 * ks + 4);
                      cv[0] = b0.x; cv[1] = b0.y; cv[2] = b0.z; cv[3] = b0.w; cv[4] = b1.x; cv[5] = b1.y; cv[6] = b1.z; cv[7] = b1.w; }
#pragma unroll
                    for (int t = 0; t < 4; ++t) { const f32x4 w0 = *(const LAS f32x4*)(cwl + t * 384 + 16 * ks), w1 = *(const LAS f32x4*)(cwl + t * 384 + 16 * ks + 4); const u32x4 u = ux[t][k2];
                        cv[0] += w0.x * bflo(u.x); cv[1] += w0.y * bfhi(u.x); cv[2] += w0.z * bflo(u.y); cv[3] += w0.w * bfhi(u.y);
                        cv[4] += w1.x * bflo(u.z); cv[5] += w1.y * bfhi(u.z); cv[6] += w1.z * bflo(u.w); cv[7] += w1.w * bfhi(u.w); }
                    { u32x4 w; w.x = pk2(cv[0], cv[1]); w.y = pk2(cv[2], cv[3]); w.z = pk2(cv[4], cv[5]); w.w = pk2(cv[6], cv[7]); af[ks] = __builtin_bit_cast(bf16x8, w); }
                    LAS float* tp = Tw + r * LRU_T_STR + 16 * ks + 8 * h;
#pragma unroll
                    for (int j = 0; j < 8; ++j) tp[j] = cv[j];
                }
            }
            float xv[16];
#pragma unroll
            for (int v = 0; v < 16; ++v) xv[v] = Tw[((v & 3) + 8 * (v >> 2) + 4 * h) * LRU_T_STR + 32 * chalf + r];
            float y[16];
#pragma unroll
            for (int v = 0; v < 16; ++v) y[v] = 0.f;
#pragma unroll
            for (int dir = 0; dir < 2; ++dir) {
                f32x16 pa, px;
#pragma unroll
                for (int v = 0; v < 16; ++v) { pa[v] = 0.f; px[v] = 0.f; }
#pragma unroll
                for (int ks = 0; ks < 4; ++ks) { pa = MFMA32(af[ks], wfa[dir][ks], pa); px = MFMA32(af[ks], wfx[dir][ks], px); }
                float av[16], uv[16];
#pragma unroll
                for (int v = 0; v < 16; ++v) { const float rg = sigmoidf_(pa[v] + ba_[dir]), ig = sigmoidf_(px[v] + bx_[dir]);
                    const float l2 = k1[dir] * rg, aa = __builtin_amdgcn_exp2f(l2); av[v] = aa;
                    const float x2 = l2 * 1.3862943611198906f;
                    const float pl = x2 * (1.f + x2 * (0.5f + x2 * (0.16666667f + x2 * (0.041666668f + x2 * (0.0083333338f + x2 * 0.0013888889f)))));
                    const float om = x2 > -0.25f ? -pl : fmaf(-aa, aa, 1.0f);
                    uv[v] = __builtin_amdgcn_sqrtf(om) * (ig * xv[v]); }
                float GA[4], GU[4];
#pragma unroll
                for (int q = 0; q < 4; ++q) { float A = 1.f, U = 0.f;
#pragma unroll
                    for (int cc = 0; cc < 4; ++cc) { const int c2 = dir == 0 ? cc : 3 - cc; const int v = 4 * q + c2; U = av[v] * U + uv[v]; A = av[v] * A; }
                    GA[q] = A; GU[q] = U; }
                float OA[4], OU[4];
#pragma unroll
                for (int q = 0; q < 4; ++q) { OA[q] = xhalf(GA[q]); OU[q] = xhalf(GU[q]); }
                float LA[8], LU[8];
#pragma unroll
                for (int q = 0; q < 4; ++q) { LA[2 * q] = h == 0 ? GA[q] : OA[q]; LU[2 * q] = h == 0 ? GU[q] : OU[q]; LA[2 * q + 1] = h == 1 ? GA[q] : OA[q]; LU[2 * q + 1] = h == 1 ? GU[q] : OU[q]; }
                if (!FINAL) {
                    float A = 1.f, U = 0.f;
#pragma unroll
                    for (int gg = 0; gg < 8; ++gg) { const int gi = dir == 0 ? gg : 7 - gg; U = LA[gi] * U + LU[gi]; A = LA[gi] * A; }
                    if (h == 0) { float2 o; o.x = A; o.y = U; ((float2*)(a->ws + OFF_LRUS))[(size_t)((b * 2 + dir) * NCHUNK + chunk) * 384 + ch] = o; }
                } else {
                    float X = ((const float*)(a->ws + OFF_LRUC))[(size_t)((b * 2 + dir) * NCHUNK + chunk) * 384 + ch];
                    float XE[4];
#pragma unroll
                    for (int q = 0; q < 4; ++q) XE[q] = 0.f;
#pragma unroll
                    for (int gg = 0; gg < 8; ++gg) { const int gi = dir == 0 ? gg : 7 - gg; if ((gi & 1) == h) XE[gi >> 1] = X; X = LA[gi] * X + LU[gi]; }
#pragma unroll
                    for (int q = 0; q < 4; ++q) { float x = XE[q];
#pragma unroll
                        for (int cc = 0; cc < 4; ++cc) { const int c2 = dir == 0 ? cc : 3 - cc; const int v = 4 * q + c2; x = av[v] * x + uv[v]; y[v] += x; } }
                }
            }
            if (FINAL) {
#pragma unroll
                for (int v = 0; v < 16; ++v) Tw[((v & 3) + 8 * (v >> 2) + 4 * h) * LRU_T_STR + r] = y[v];
                const bf16_t* zl = Z + (size_t)(R0 + r) * INW + Z_LG + 32 * g + 16 * h;
                const u32x4 l0 = *(const u32x4*)zl, l1 = *(const u32x4*)(zl + 8);
                const unsigned lw[8] = {l0.x, l0.y, l0.z, l0.w, l1.x, l1.y, l1.z, l1.w}; unsigned ow[8];
#pragma unroll
                for (int j = 0; j < 8; ++j) { const float y0 = Tw[r * LRU_T_STR + 16 * h + 2 * j], y1 = Tw[r * LRU_T_STR + 16 * h + 2 * j + 1]; const float g0 = bflo(lw[j]), g1 = bfhi(lw[j]);
                    const float e0 = g0 * sigmoidf_(1.5957691216057308f * (g0 + 0.044715f * g0 * g0 * g0)), e1 = g1 * sigmoidf_(1.5957691216057308f * (g1 + 0.044715f * g1 * g1 * g1));
                    ow[j] = pk2(y0 * e0, y1 * e1); }
                bf16_t* yo = (bf16_t*)(a->ws + OFF_XN) + (size_t)(R0 + r) * D + 32 * g + 16 * h;
                u32x4 o0 = {ow[0], ow[1], ow[2], ow[3]}, o1 = {ow[4], ow[5], ow[6], ow[7]}; *(u32x4*)yo = o0; *(u32x4*)(yo + 8) = o1;
            }
        }
    }
    __syncthreads();
}

__device__ __forceinline__ void mixprep_rows(ArgP a, int l, int gw, int NGW, int lane) {
    const bf16_t* Z = (const bf16_t*)(a->ws + OFF_Z);
    const float* qn = a->in[19] + l * 256; const float* kvn = a->in[21] + l * 128; const float* nqg = a->in[25] + l * 64; const float* nkg = a->in[26] + l * 64;
    const float nscale = 0.125f * LOG2E;
    const f32x4 gq = *(const f32x4*)(qn + 4 * lane); const float gkv0 = kvn[2 * lane], gkv1 = kvn[2 * lane + 1];
    const int hd = lane >> 4, d0 = 4 * (lane & 15);
    const f32x4 gnq = *(const f32x4*)(nqg + d0), gnk = *(const f32x4*)(nkg + d0);
    for (int row0 = gw * 4; row0 < MTOT; row0 += NGW * 4) {
        u32x2 ucq[4], unq[4], unk[4]; unsigned uckv[4];
#pragma unroll
        for (int t4 = 0; t4 < 4; ++t4) { const bf16_t* zr = Z + (size_t)(row0 + t4) * INW;
            ucq[t4] = *(const u32x2*)(zr + Z_CQ + 4 * lane); uckv[t4] = *(const unsigned*)(zr + Z_CKV + 2 * lane);
            unq[t4] = *(const u32x2*)(zr + Z_NQ + 4 * lane); unk[t4] = *(const u32x2*)(zr + Z_NK + 4 * lane); }
#pragma unroll
        for (int t4 = 0; t4 < 4; ++t4) {
            const int row = row0 + t4; int b, p; if (row < MLAT) { b = row >> 13; p = 256 + (row & 8191); } else { b = (row - MLAT) >> 8; p = (row - MLAT) & 255; }
            { const u32x2 u = ucq[t4]; float v0 = bflo(u.x), v1 = bfhi(u.x), v2 = bflo(u.y), v3 = bfhi(u.y);
              const float rstd = 1.f / sqrtf(wave_sum(v0 * v0 + v1 * v1 + v2 * v2 + v3 * v3) * (1.f / 256) + EPS);
              u32x2 o; o.x = pk2(v0 * rstd * gq.x, v1 * rstd * gq.y); o.y = pk2(v2 * rstd * gq.z, v3 * rstd * gq.w);
              *(u32x2*)((bf16_t*)(a->ws + OFF_CQN) + (size_t)row * 256 + 4 * lane) = o; }
            { const unsigned u = uckv[t4]; float v0 = bflo(u), v1 = bfhi(u);
              const float rstd = 1.f / sqrtf(wave_sum(v0 * v0 + v1 * v1) * (1.f / 128) + EPS);
              bf16_t* o = (bf16_t*)(a->ws + OFF_CKVN) + (size_t)row * 256;
              *(unsigned*)(o + 2 * lane) = pk2(v0 * rstd * gkv0, v1 * rstd * gkv1); *(unsigned*)(o + 128 + 2 * lane) = 0u; }
            { const u32x2 u = unq[t4]; float v0 = bflo(u.x), v1 = bfhi(u.x), v2 = bflo(u.y), v3 = bfhi(u.y);
              float sq = v0 * v0 + v1 * v1 + v2 * v2 + v3 * v3; sq = row16_sum(sq);
              const float rstd = nscale / sqrtf(sq * (1.f / 64) + EPS);
              u32x2 o; o.x = pk2(v0 * rstd * gnq.x, v1 * rstd * gnq.y); o.y = pk2(v2 * rstd * gnq.z, v3 * rstd * gnq.w);
              *(u32x2*)((bf16_t*)(a->ws + OFF_NQ) + ((size_t)(b * 4 + hd) * P + p) * 64 + d0) = o; }
            { const u32x2 u = unk[t4]; float v0 = bflo(u.x), v1 = bfhi(u.x), v2 = bflo(u.y), v3 = bfhi(u.y);
              float sq = v0 * v0 + v1 * v1 + v2 * v2 + v3 * v3; sq = row16_sum(sq);
              const float rstd = 1.f / sqrtf(sq * (1.f / 64) + EPS);
              u32x2 o; o.x = pk2(v0 * rstd * gnk.x, v1 * rstd * gnk.y); o.y = pk2(v2 * rstd * gnk.z, v3 * rstd * gnk.w);
              *(u32x2*)((bf16_t*)(a->ws + OFF_NK) + ((size_t)(b * 4 + hd) * P + p) * 64 + d0) = o; }
        }
    }
}
constexpr int NVT_STR = 516;
__device__ __forceinline__ void mixprep_tile(ArgP a, int l, int tl, LAS unsigned char* lds, int tid, int wave, int lane, int pm) {
    const TileGeo g = tile_geo(tl);
    LAS unsigned char* nvt = lds;
    const bf16_t* Z = (const bf16_t*)(a->ws + OFF_Z);
    { u32x2 unv[8];
#pragma unroll
      for (int ii = 0; ii < 8; ++ii) unv[ii] = *(const u32x2*)(Z + (size_t)(g.R0 + wave * 8 + ii) * INW + Z_NV + 4 * lane);
#pragma unroll
      for (int ii = 0; ii < 8; ++ii) { const int i = wave * 8 + ii; *(LAS unsigned*)(nvt + i * NVT_STR + 8 * lane) = unv[ii].x; *(LAS unsigned*)(nvt + i * NVT_STR + 8 * lane + 4) = unv[ii].y; } }
    __syncthreads();
    {
        const int rowid = tid >> 1, half = tid & 1; unsigned w[16];
#pragma unroll
        for (int j = 0; j < 16; ++j) { const unsigned lo = *(const LAS bf16_t*)(nvt + (half * 32 + 2 * j) * NVT_STR + rowid * 2), hi = *(const LAS bf16_t*)(nvt + (half * 32 + 2 * j + 1) * NVT_STR + rowid * 2); w[j] = lo | (hi << 16); }
        bf16_t* dst = (bf16_t*)(a->ws + OFF_NVT) + ((size_t)(g.b * 4 + (rowid >> 6)) * 64 + (rowid & 63)) * P + g.p0 + 32 * half;
#pragma unroll
        for (int j = 0; j < 4; ++j) { u32x4 o = {w[4 * j], w[4 * j + 1], w[4 * j + 2], w[4 * j + 3]}; *(u32x4*)(dst + 8 * j) = o; }
    }
    __syncthreads();
}

__device__ __forceinline__ void mlapost_rows(ArgP a, int l, int gw, int NGW, int lane) {
    const bf16_t* Z = (const bf16_t*)(a->ws + OFF_Z); const bf16_t* QR = (const bf16_t*)(a->ws + OFF_QRAW); const bf16_t* KVR = (const bf16_t*)(a->ws + OFF_KVRAW);
    const float* rope = (const float*)(a->ws + OFF_ROPE);
    const float qscale = 0.10206207261596575f * LOG2E;
    const int rw = lane >> 4, c = lane & 15; const bool act = c < 12, isrope = c >= 8 && c < 12;
    const int cc = act ? c : 0;
    const f32x4 gq0 = *(const f32x4*)(a->in[23] + l * 96 + 8 * cc), gq1 = *(const f32x4*)(a->in[23] + l * 96 + 8 * cc + 4);
    const f32x4 gk0 = *(const f32x4*)(a->in[24] + l * 96 + 8 * cc), gk1 = *(const f32x4*)(a->in[24] + l * 96 + 8 * cc + 4);
    const int axis = (c >> 1) & 1, hf = c & 1;
    constexpr int NGRP = MTOT * 12 / 4;
    for (int g0 = gw * 4; g0 < NGRP; g0 += NGW * 4) {
        u32x4 uin[4];
#pragma unroll
        for (int u = 0; u < 4; ++u) { const int item = (g0 + u) * 4 + rw; const size_t row = (size_t)(item / 12); const int hq = item % 12;
            const bf16_t* src = hq < 6 ? QR + row * 576 + hq * 96 + 8 * cc : (cc < 8 ? KVR + row * 768 + (hq - 6) * 128 + 8 * cc : Z + row * INW + Z_KR + 8 * (cc - 8));
            uin[u] = *(const u32x4*)src; }
#pragma unroll
        for (int u = 0; u < 4; ++u) { const int item = (g0 + u) * 4 + rw; const int row = item / 12, hq = item % 12; const bool isq = hq < 6; const int hh = isq ? hq : hq - 6;
            int b, p, t; const bool latent = row < MLAT;
            if (latent) { b = row >> 13; t = row & 8191; p = 256 + t; } else { b = (row - MLAT) >> 8; p = (row - MLAT) & 255; t = 0; }
            float v[8]; v[0] = bflo(uin[u].x); v[1] = bfhi(uin[u].x); v[2] = bflo(uin[u].y); v[3] = bfhi(uin[u].y); v[4] = bflo(uin[u].z); v[5] = bfhi(uin[u].z); v[6] = bflo(uin[u].w); v[7] = bfhi(uin[u].w);
            float ss = 0.f;
#pragma unroll
            for (int j = 0; j < 8; ++j) ss += v[j] * v[j];
            ss = act ? ss : 0.f;
            const float rstd = 1.f / sqrtf(row16_sum(ss) * (1.f / 96) + EPS);
            const f32x4 ga = isq ? gq0 : gk0, gb = isq ? gq1 : gk1;
            v[0] *= rstd * ga.x; v[1] *= rstd * ga.y; v[2] *= rstd * ga.z; v[3] *= rstd * ga.w; v[4] *= rstd * gb.x; v[5] *= rstd * gb.y; v[6] *= rstd * gb.z; v[7] *= rstd * gb.w;
            float o[8];
#pragma unroll
            for (int j = 0; j < 8; ++j) o[j] = dppf<0xB1>(v[j]);
            if (latent && isrope) { const int pos = axis == 0 ? (t >> 6) : (t & 63); const float* rp = rope + pos * 16;
                const f32x4 r0 = *(const f32x4*)rp, r1 = *(const f32x4*)(rp + 4), r2 = *(const f32x4*)(rp + 8), r3 = *(const f32x4*)(rp + 12);
                const float cs[8] = {r0.x, r0.z, r1.x, r1.z, r2.x, r2.z, r3.x, r3.z}, sn[8] = {r0.y, r0.w, r1.y, r1.w, r2.y, r2.w, r3.y, r3.w};
#pragma unroll
                for (int j = 0; j < 8; ++j) v[j] = hf == 0 ? v[j] * cs[j] - o[j] * sn[j] : v[j] * cs[j] + o[j] * sn[j]; }
            const float sc = isq ? qscale : 1.0f;
            u32x4 w; w.x = pk2(v[0] * sc, v[1] * sc); w.y = pk2(v[2] * sc, v[3] * sc); w.z = pk2(v[4] * sc, v[5] * sc); w.w = pk2(v[6] * sc, v[7] * sc);
            bf16_t* dst = (bf16_t*)(a->ws + (isq ? OFF_QM : OFF_KM)) + ((size_t)(b * 6 + hh) * P + p) * 96 + 8 * cc;
            if (act) *(u32x4*)dst = w; }
    }
}
constexpr int MVT_STR = 784;
__device__ __forceinline__ void mlapost_tile(ArgP a, int l, int tl, LAS unsigned char* lds, int tid, int wave, int lane, int pm) {
    const TileGeo g = tile_geo(tl);
    const bf16_t* KVR = (const bf16_t*)(a->ws + OFF_KVRAW);
    { u32x4 uv[6];
#pragma unroll
      for (int k = 0; k < 6; ++k) { const int idx = tid + k * NTHR, tok = idx / 48, ch = idx % 48; uv[k] = *(const u32x4*)(KVR + (size_t)(g.R0 + tok) * 768 + (ch >> 3) * 128 + 64 + (ch & 7) * 8); }
#pragma unroll
      for (int k = 0; k < 6; ++k) { const int idx = tid + k * NTHR, tok = idx / 48, ch = idx % 48; *(LAS u32x4*)(lds + tok * MVT_STR + ch * 16) = uv[k]; } }
    __syncthreads();
    for (int rowid = tid >> 1; rowid < 384; rowid += 256) { const int half = tid & 1; unsigned w[16];
#pragma unroll
        for (int j = 0; j < 16; ++j) { const unsigned lo = *(const LAS bf16_t*)(lds + (half * 32 + 2 * j) * MVT_STR + rowid * 2), hi = *(const LAS bf16_t*)(lds + (half * 32 + 2 * j + 1) * MVT_STR + rowid * 2); w[j] = lo | (hi << 16); }
        bf16_t* dst = (bf16_t*)(a->ws + OFF_VMT) + ((size_t)(g.b * 6 + rowid / 64) * 64 + (rowid & 63)) * P + g.p0 + 32 * half;
#pragma unroll
        for (int j = 0; j < 4; ++j) { u32x4 o = {w[4 * j], w[4 * j + 1], w[4 * j + 2], w[4 * j + 3]}; *(u32x4*)(dst + 8 * j) = o; }
    }
    __syncthreads();
}

__device__ __forceinline__ float max3f(float a, float b, float c) { float r; asm("v_max3_f32 %0, %1, %2, %3" : "=v"(r) : "v"(a), "v"(b), "v"(c)); return r; }
__device__ __forceinline__ unsigned pkrtz(float lo, float hi) { return __builtin_bit_cast(unsigned, __builtin_amdgcn_cvt_pkrtz(lo, hi)); }
template <bool NA>
__device__ __forceinline__ void att_softmax_pv(f32x16& S0, f32x16& S1, const float mref, f32x16& O0, f32x16& O1, f32x16& O2, float& mrun, const LAS unsigned char* vb, int r, int h, bool local, const LAS float* bp, int wst) {
    if (NA && local) {
#pragma unroll
        for (int v = 0; v < 16; ++v) { const int kc0 = 16 * (v >> 3) + 8 * h + (v & 7), kc1 = kc0 + 32;
            S0[v] = (kc0 >= wst && kc0 < wst + 16) ? S0[v] + bp[kc0] : -INFINITY; S1[v] = (kc1 >= wst && kc1 < wst + 16) ? S1[v] + bp[kc1] : -INFINITY; }
    }
    float mx = max3f(S0[0], S0[1], S0[2]);
    mx = max3f(mx, S0[3], S0[4]); mx = max3f(mx, S0[5], S0[6]); mx = max3f(mx, S0[7], S0[8]); mx = max3f(mx, S0[9], S0[10]); mx = max3f(mx, S0[11], S0[12]); mx = max3f(mx, S0[13], S0[14]);
    mx = max3f(mx, S0[15], S1[0]); mx = max3f(mx, S1[1], S1[2]); mx = max3f(mx, S1[3], S1[4]); mx = max3f(mx, S1[5], S1[6]); mx = max3f(mx, S1[7], S1[8]); mx = max3f(mx, S1[9], S1[10]);
    mx = max3f(mx, S1[11], S1[12]); mx = max3f(mx, S1[13], S1[14]); mx = fmaxf(mx, S1[15]);
    mx = xhalf_max(mx);
    const float mabs = mref + mx;
    if (__builtin_amdgcn_ballot_w64((mref != mrun) || ((mabs - mrun) > 8.0f)) != 0ull) {
        const float mnew = fmaxf(mrun, mabs), alpha = __builtin_amdgcn_exp2f(mrun - mnew), d = mnew - mref; mrun = mnew;
#pragma unroll
        for (int v = 0; v < 16; ++v) { O0[v] *= alpha; O1[v] *= alpha; O2[v] *= alpha; S0[v] -= d; S1[v] -= d; }
    }
    bf16x8 pf[4];
    { float e0[16], e1[16];
#pragma unroll
      for (int v = 0; v < 16; ++v) { e0[v] = __builtin_amdgcn_exp2f(S0[v]); e1[v] = __builtin_amdgcn_exp2f(S1[v]); }
      u32x4 w;
      w.x = pkrtz(e0[0], e0[1]); w.y = pkrtz(e0[2], e0[3]); w.z = pkrtz(e0[4], e0[5]); w.w = pkrtz(e0[6], e0[7]); pf[0] = __builtin_bit_cast(bf16x8, w);
      w.x = pkrtz(e0[8], e0[9]); w.y = pkrtz(e0[10], e0[11]); w.z = pkrtz(e0[12], e0[13]); w.w = pkrtz(e0[14], e0[15]); pf[1] = __builtin_bit_cast(bf16x8, w);
      w.x = pkrtz(e1[0], e1[1]); w.y = pkrtz(e1[2], e1[3]); w.z = pkrtz(e1[4], e1[5]); w.w = pkrtz(e1[6], e1[7]); pf[2] = __builtin_bit_cast(bf16x8, w);
      w.x = pkrtz(e1[8], e1[9]); w.y = pkrtz(e1[10], e1[11]); w.z = pkrtz(e1[12], e1[13]); w.w = pkrtz(e1[14], e1[15]); pf[3] = __builtin_bit_cast(bf16x8, w); }
    const bf16x8 ones = {0x3C00, 0x3C00, 0x3C00, 0x3C00, 0x3C00, 0x3C00, 0x3C00, 0x3C00};
#pragma unroll
    for (int kk = 0; kk < 4; ++kk) { const bf16x8 v0 = *(const LAS bf16x8*)(vb + r * 144 + kk * 32 + h * 16), v1 = *(const LAS bf16x8*)(vb + (32 + r) * 144 + kk * 32 + h * 16);
        O0 = MFMA32(v0, pf[kk], O0); O1 = MFMA32(v1, pf[kk], O1); O2 = MFMA32(ones, pf[kk], O2); }
}
template <int DQK, bool NA>
__device__ __forceinline__ void attn_unit(LAS unsigned char* lds, const bf16_t* __restrict__ Qb, const bf16_t* __restrict__ Kb, const bf16_t* __restrict__ Vtb,
                                          bf16_t* __restrict__ Yb  , int qb, const LAS float* rpbh, int tid) {
    constexpr int KSTR = (DQK + 8) * 2, VSTR = 144, KBUF = 64 * KSTR, VBUF = 64 * VSTR, KPR = DQK / 8, NKP = 64 * KPR, NKS = DQK / 16;
    static_assert(2 * KBUF + 2 * VBUF <= 49152, "attention LDS");
    const int wave = tid >> 6, lane = tid & 63, r = lane & 31, h = lane >> 5;
    int n_tiles, rlo = 0;
    if (qb == 0) n_tiles = 4;
    else if (!NA) n_tiles = P / 64;
    else { const int R = 4 * (qb - 1); rlo = clampi(R - 4, 0, 120); const int rhi = clampi(R - 1, 0, 120) + 7; n_tiles = 4 + rhi - rlo + 1; }
    const int wrow = 4 * (qb - 1) + (wave >> 1);
    const int r0w = clampi(wrow - 4, 0, 120);
    const int qc = 32 * (wave & 1) + r, wst = clampi(qc - 8, 0, 48);
    const int pq = 256 * qb + 32 * wave + r;
    bf16x8 qf[NKS];
#pragma unroll
    for (int ks = 0; ks < NKS; ++ks) qf[ks] = *(const bf16x8*)(Qb + (size_t)pq * DQK + 16 * ks + 8 * h);
    f32x16 O0, O1, O2;
#pragma unroll
    for (int v = 0; v < 16; ++v) { O0[v] = 0.f; O1[v] = 0.f; O2[v] = 0.f; }
    float mrun = -1e30f;
    const int krow = (r & ~12) | ((r & 4) << 1) | ((r & 8) >> 1);
#define ATT_TILE(it) ((NA && (it) >= 4) ? 4 + rlo + ((it) - 4) : (it))
#define ATT_ACT(it) (!(NA && (it) >= 4) || ((rlo + (it) - 4) >= r0w && (rlo + (it) - 4) <= r0w + 7))
#define ATT_LOADK(it, K0_, K1_) do { const bf16_t* kp_ = Kb + (size_t)ATT_TILE(it) * 64 * DQK; K0_ = *(const u32x4*)(kp_ + tid * 8); \
        if (NKP > 512) { if (tid < NKP - 512) K1_ = *(const u32x4*)(kp_ + (tid + 512) * 8); } } while (0)
#define ATT_LOADV(it, V_) do { V_ = *(const u32x4*)(Vtb + (size_t)(tid >> 3) * P + ATT_TILE(it) * 64 + (tid & 7) * 8); } while (0)
#define ATT_STOREK(slot, K0_, K1_) do { LAS unsigned char* bb_ = lds + (slot) * KBUF; *(LAS u32x4*)(bb_ + (tid / KPR) * KSTR + (tid % KPR) * 16) = K0_; \
        if (NKP > 512) { if (tid < NKP - 512) { const int i_ = tid + 512; *(LAS u32x4*)(bb_ + (i_ / KPR) * KSTR + (i_ % KPR) * 16) = K1_; } } } while (0)
#define ATT_STOREV(slot, V_) do { *(LAS u32x4*)(lds + 2 * KBUF + (slot) * VBUF + (tid >> 3) * VSTR + (tid & 7) * 16) = V_; } while (0)
#define ATT_QK(Sa, Sb, slot, mref_) do { const LAS unsigned char* kb_ = lds + (slot) * KBUF; const float ni_ = -(mref_); _Pragma("unroll") for (int v = 0; v < 16; ++v) { Sa[v] = ni_; Sb[v] = ni_; } \
        _Pragma("unroll") for (int ks = 0; ks < NKS; ++ks) { const bf16x8 a0 = *(const LAS bf16x8*)(kb_ + krow * KSTR + ks * 32 + h * 16), a1 = *(const LAS bf16x8*)(kb_ + (32 + krow) * KSTR + ks * 32 + h * 16); \
            Sa = MFMA32(a0, qf[ks], Sa); Sb = MFMA32(a1, qf[ks], Sb); } } while (0)
#define ATT_BODY(it, C0, C1, mrefC, N0, N1, mrefN, LK0, LK1, LV, SK0, SK1, SV) do { \
        if ((it) + 3 < n_tiles) ATT_LOADK((it) + 3, LK0, LK1); \
        if ((it) + 2 < n_tiles) ATT_LOADV((it) + 2, LV); \
        mrefN = (it) == 0 ? 0.f : mrun;                                \
        if (!NA || ((it) + 1 < n_tiles && ATT_ACT((it) + 1))) ATT_QK(N0, N1, ((it) + 1) & 1, mrefN);     \
        if (ATT_ACT(it)) { const int kr_ = rlo + (it) - 4; \
            att_softmax_pv<NA>(C0, C1, mrefC, O0, O1, O2, mrun, lds + 2 * KBUF + ((it) & 1) * VBUF, r, h, NA && (it) >= 4, rpbh + (kr_ - wrow + 7) * 31 + 15 - qc, wst); } \
        if ((it) + 2 < n_tiles) ATT_STOREK((it) & 1, SK0, SK1); \
        if ((it) + 1 < n_tiles) ATT_STOREV(((it) + 1) & 1, SV); \
        __syncthreads(); } while (0)
    u32x4 ka0, ka1 = {0u, 0u, 0u, 0u}, va, kb0, kb1 = {0u, 0u, 0u, 0u}, vb;
    ATT_LOADK(0, ka0, ka1); ATT_LOADV(0, va); ATT_LOADK(1, kb0, kb1);
    ATT_STOREK(0, ka0, ka1); ATT_STOREV(0, va); ATT_STOREK(1, kb0, kb1);
    ATT_LOADK(2, kb0, kb1); ATT_LOADV(1, vb);
    __syncthreads();
    f32x16 A0, A1, B0, B1; float mrefA = 0.f, mrefB = 0.f;
    ATT_QK(A0, A1, 0, mrefA);
    for (int it = 0; it < n_tiles; it += 2) {
        ATT_BODY(it, A0, A1, mrefA, B0, B1, mrefB, ka0, ka1, va, kb0, kb1, vb);
        if (it + 1 < n_tiles) ATT_BODY(it + 1, B0, B1, mrefB, A0, A1, mrefA, kb0, kb1, vb, ka0, ka1, va);
    }
#undef ATT_TILE
#undef ATT_ACT
#undef ATT_LOADK
#undef ATT_LOADV
#undef ATT_STOREK
#undef ATT_STOREV
#undef ATT_QK
#undef ATT_BODY
    const float inv = 1.f / O2[0];
    bf16_t* yr = Yb + (size_t)(32 * wave + r) * D;
#pragma unroll
    for (int q = 0; q < 4; ++q) { u32x2 o;
        o.x = pg8::cvt_pk_bf16(O0[4 * q] * inv, O0[4 * q + 1] * inv); o.y = pg8::cvt_pk_bf16(O0[4 * q + 2] * inv, O0[4 * q + 3] * inv); *(u32x2*)(yr + 8 * q + 4 * h) = o;
        o.x = pg8::cvt_pk_bf16(O1[4 * q] * inv, O1[4 * q + 1] * inv); o.y = pg8::cvt_pk_bf16(O1[4 * q + 2] * inv, O1[4 * q + 3] * inv); *(u32x2*)(yr + 32 + 8 * q + 4 * h) = o; }
}

__device__ __forceinline__ void att64_softmax(f32x16& S0, f32x16& S1, f32x16& O0, f32x16& O1, float& mrun, float& lsum, bf16x8 (&pf)[4], const bool first) {
    float mx = max3f(S0[0], S0[1], S0[2]);
    mx = max3f(mx, S0[3], S0[4]); mx = max3f(mx, S0[5], S0[6]); mx = max3f(mx, S0[7], S0[8]); mx = max3f(mx, S0[9], S0[10]); mx = max3f(mx, S0[11], S0[12]); mx = max3f(mx, S0[13], S0[14]);
    mx = max3f(mx, S0[15], S1[0]); mx = max3f(mx, S1[1], S1[2]); mx = max3f(mx, S1[3], S1[4]); mx = max3f(mx, S1[5], S1[6]); mx = max3f(mx, S1[7], S1[8]); mx = max3f(mx, S1[9], S1[10]);
    mx = max3f(mx, S1[11], S1[12]); mx = max3f(mx, S1[13], S1[14]); mx = fmaxf(mx, S1[15]);
    mx = xhalf_max(mx);
    if (first || __builtin_amdgcn_ballot_w64(mx > 8.0f) != 0ull) {
        const float d = first ? mx : fmaxf(mx, 0.f), alpha = first ? 0.f : __builtin_amdgcn_exp2f(-d); mrun += d; lsum *= alpha;
#pragma unroll
        for (int v = 0; v < 16; ++v) { O0[v] *= alpha; O1[v] *= alpha; S0[v] -= d; S1[v] -= d; }
    }
    float e0[16], e1[16]; float ps = 0.f;
#pragma unroll
    for (int v = 0; v < 16; ++v) { e0[v] = __builtin_amdgcn_exp2f(S0[v]); e1[v] = __builtin_amdgcn_exp2f(S1[v]); ps += e0[v] + e1[v]; }
    lsum += ps;
    u32x4 w;
    w.x = pkrtz(e0[0], e0[1]); w.y = pkrtz(e0[2], e0[3]); w.z = pkrtz(e0[4], e0[5]); w.w = pkrtz(e0[6], e0[7]); pf[0] = __builtin_bit_cast(bf16x8, w);
    w.x = pkrtz(e0[8], e0[9]); w.y = pkrtz(e0[10], e0[11]); w.z = pkrtz(e0[12], e0[13]); w.w = pkrtz(e0[14], e0[15]); pf[1] = __builtin_bit_cast(bf16x8, w);
    w.x = pkrtz(e1[0], e1[1]); w.y = pkrtz(e1[2], e1[3]); w.z = pkrtz(e1[4], e1[5]); w.w = pkrtz(e1[6], e1[7]); pf[2] = __builtin_bit_cast(bf16x8, w);
    w.x = pkrtz(e1[8], e1[9]); w.y = pkrtz(e1[10], e1[11]); w.z = pkrtz(e1[12], e1[13]); w.w = pkrtz(e1[14], e1[15]); pf[3] = __builtin_bit_cast(bf16x8, w);
}
__device__ __forceinline__ void attn_unit_mla64(LAS unsigned char* lds, const bf16_t* __restrict__ Qb, const bf16_t* __restrict__ Kb, const bf16_t* __restrict__ Vtb, bf16_t* __restrict__ Yb  , int qb, int tid_in) {
    constexpr int DQK = 96, KSTR = 208, VSTR = 144, KBUF = 64 * KSTR, VBUF = 64 * VSTR, NKS = 6;
    int tid = tid_in; asm volatile("" : "+v"(tid));
    const int wave = tid >> 6, lane = tid & 63, r = lane & 31, h = lane >> 5;
    constexpr int n_tiles = P / 64;
    const int pq = 256 + 512 * qb + 64 * wave + r;
    bf16x8 qa[NKS], qc[NKS];
#pragma unroll
    for (int ks = 0; ks < NKS; ++ks) { qa[ks] = *(const bf16x8*)(Qb + (size_t)pq * DQK + 16 * ks + 8 * h); qc[ks] = *(const bf16x8*)(Qb + (size_t)(pq + 32) * DQK + 16 * ks + 8 * h); }
    f32x16 Oa0, Oa1, Oc0, Oc1;
#pragma unroll
    for (int v = 0; v < 16; ++v) { Oa0[v] = 0.f; Oa1[v] = 0.f; Oc0[v] = 0.f; Oc1[v] = 0.f; }
    float mra = -1e30f, mrc = -1e30f, lsa = 0.f, lsc = 0.f;
    const int krow = (r & ~12) | ((r & 4) << 1) | ((r & 8) >> 1);
    u32x4 k0, k1 = {0u, 0u, 0u, 0u}, vv;
#define A6_LOAD(it) do { const bf16_t* kp_ = Kb + (size_t)(it) * 64 * DQK; k0 = *(const u32x4*)(kp_ + tid * 8); if (tid < 256) k1 = *(const u32x4*)(kp_ + (tid + 512) * 8); \
        vv = *(const u32x4*)(Vtb + (size_t)(tid >> 3) * P + (it) * 64 + (tid & 7) * 8); } while (0)
#define A6_STORE(slot) do { LAS unsigned char* bb_ = lds + (slot) * KBUF; *(LAS u32x4*)(bb_ + (tid / 12) * KSTR + (tid % 12) * 16) = k0; \
        if (tid < 256) { const int i_ = tid + 512; *(LAS u32x4*)(bb_ + (i_ / 12) * KSTR + (i_ % 12) * 16) = k1; } \
        *(LAS u32x4*)(lds + 2 * KBUF + (slot) * VBUF + (tid >> 3) * VSTR + (tid & 7) * 16) = vv; } while (0)
    A6_LOAD(0); A6_STORE(0);
    __syncthreads();
    for (int it = 0; it < n_tiles; ++it) {
        if (it + 1 < n_tiles) A6_LOAD(it + 1);
        const LAS unsigned char* kb_ = lds + (it & 1) * KBUF; const LAS unsigned char* vb_ = lds + 2 * KBUF + (it & 1) * VBUF;
        f32x16 Sa0, Sa1, Sc0, Sc1;
        { const float na = it == 0 ? 0.f : -mra, nc = it == 0 ? 0.f : -mrc;
#pragma unroll
          for (int v = 0; v < 16; ++v) { Sa0[v] = na; Sa1[v] = na; Sc0[v] = nc; Sc1[v] = nc; } }
#pragma unroll
        for (int ks = 0; ks < NKS; ++ks) { const bf16x8 a0 = *(const LAS bf16x8*)(kb_ + krow * KSTR + ks * 32 + h * 16), a1 = *(const LAS bf16x8*)(kb_ + (32 + krow) * KSTR + ks * 32 + h * 16);
            Sa0 = MFMA32(a0, qa[ks], Sa0); Sa1 = MFMA32(a1, qa[ks], Sa1); Sc0 = MFMA32(a0, qc[ks], Sc0); Sc1 = MFMA32(a1, qc[ks], Sc1); }
        if (it == 0) { mra = 0.f; mrc = 0.f; }
        bf16x8 pa[4], pc[4];
        att64_softmax(Sa0, Sa1, Oa0, Oa1, mra, lsa, pa, it == 0);
        att64_softmax(Sc0, Sc1, Oc0, Oc1, mrc, lsc, pc, it == 0);
#pragma unroll
        for (int kk = 0; kk < 4; ++kk) { const bf16x8 v0 = *(const LAS bf16x8*)(vb_ + r * VSTR + kk * 32 + h * 16), v1 = *(const LAS bf16x8*)(vb_ + (32 + r) * VSTR + kk * 32 + h * 16);
            Oa0 = MFMA32(v0, pa[kk], Oa0); Oa1 = MFMA32(v1, pa[kk], Oa1); Oc0 = MFMA32(v0, pc[kk], Oc0); Oc1 = MFMA32(v1, pc[kk], Oc1); }
        if (it + 1 < n_tiles) A6_STORE((it + 1) & 1);
        __syncthreads();
    }
#undef A6_LOAD
#undef A6_STORE
    const float inva = 1.f / xhalf_sum(lsa), invc = 1.f / xhalf_sum(lsc);
    bf16_t* ya = Yb + (size_t)(64 * wave + r) * D; bf16_t* yc = ya + (size_t)32 * D;
#pragma unroll
    for (int q = 0; q < 4; ++q) { u32x2 o;
        o.x = pg8::cvt_pk_bf16(Oa0[4 * q] * inva, Oa0[4 * q + 1] * inva); o.y = pg8::cvt_pk_bf16(Oa0[4 * q + 2] * inva, Oa0[4 * q + 3] * inva); *(u32x2*)(ya + 8 * q + 4 * h) = o;
        o.x = pg8::cvt_pk_bf16(Oa1[4 * q] * inva, Oa1[4 * q + 1] * inva); o.y = pg8::cvt_pk_bf16(Oa1[4 * q + 2] * inva, Oa1[4 * q + 3] * inva); *(u32x2*)(ya + 32 + 8 * q + 4 * h) = o;
        o.x = pg8::cvt_pk_bf16(Oc0[4 * q] * invc, Oc0[4 * q + 1] * invc); o.y = pg8::cvt_pk_bf16(Oc0[4 * q + 2] * invc, Oc0[4 * q + 3] * invc); *(u32x2*)(yc + 8 * q + 4 * h) = o;
        o.x = pg8::cvt_pk_bf16(Oc1[4 * q] * invc, Oc1[4 * q + 1] * invc); o.y = pg8::cvt_pk_bf16(Oc1[4 * q + 2] * invc, Oc1[4 * q + 3] * invc); *(u32x2*)(yc + 32 + 8 * q + 4 * h) = o; }
}

#define XB_TMO      128
#define XB_XCNT(j)  (256  + 64 * (j))
#define XB_XSUB(j)  (1280 + 64 * (j))
#define XB_XGEN(j)  (2304 + 64 * (j))
#define XB_TOP      3328
#define XB_TOPGEN   3392
#define XCD_BAR_WORDS 3456
#define XB_SPIN_CAP (1u << 18)

__device__ __forceinline__ unsigned xb_ld(unsigned* p)              { return __hip_atomic_load(p, __ATOMIC_RELAXED, __HIP_MEMORY_SCOPE_AGENT); }
__device__ __forceinline__ unsigned xb_add(unsigned* p, unsigned v) { return __hip_atomic_fetch_add(p, v, __ATOMIC_RELAXED, __HIP_MEMORY_SCOPE_AGENT); }
__device__ __forceinline__ unsigned xb_xcc_id() { return (unsigned)__builtin_amdgcn_s_getreg((3 << 11) | 20) & 0xFu; }
#define XB_SPIN(cond, bar) do { unsigned _sp = 0; while (cond) { __builtin_amdgcn_s_sleep(1); \
    if ((++_sp & 255u) == 0u) { if (xb_ld(&(bar)[XB_TMO])) break; if (_sp > XB_SPIN_CAP) { atomicAdd(&(bar)[XB_TMO], 1u); break; } } } } while (0)

struct XcdBarrier {
    unsigned* bar; unsigned x;
    volatile LAS unsigned* st;
};

__device__ __forceinline__ XcdBarrier xcd_barrier_post(unsigned* bar, volatile LAS unsigned* st, int tid) {
    XcdBarrier b; b.bar = bar; b.x = xb_xcc_id(); b.st = st;
    if (tid == 0) (void)xb_add(&bar[XB_XCNT(b.x)], 1u);
    return b;
}
__device__ __forceinline__ void xcd_barrier_complete(unsigned* bar, unsigned x, unsigned& nloc, unsigned& nx) {
    const unsigned G = gridDim.x * gridDim.y * gridDim.z;
    unsigned sum, cnt, mine, sp = 0u;
    for (;;) {
        sum = 0u; cnt = 0u; mine = 0u;
#pragma unroll
        for (unsigned j = 0; j < 16; ++j) { const unsigned c = xb_ld(&bar[XB_XCNT(j)]); sum += c; cnt += (c > 0u) ? 1u : 0u; mine = (j == x) ? c : mine; }
        if (sum == G) break;
        __builtin_amdgcn_s_sleep(1);
        if ((++sp & 255u) == 0u) { if (xb_ld(&bar[XB_TMO])) break; if (sp > XB_SPIN_CAP) { atomicAdd(&bar[XB_TMO], 1u); break; } }
    }
    nloc = mine > 0u ? mine : 1u; nx = cnt > 0u ? cnt : 1u;
}

__device__ __forceinline__ void xcd_barrier(const XcdBarrier& b, int tid) {
    asm volatile("s_waitcnt vmcnt(0)" ::: "memory");
    __syncthreads();
    if (tid == 0) {
        unsigned* bar = b.bar;
        __builtin_amdgcn_s_waitcnt(0);
        unsigned nloc = b.st[0], nx = b.st[1];
        if (nloc == 0u) { xcd_barrier_complete(bar, b.x, nloc, nx); b.st[0] = nloc; b.st[1] = nx; }
        const unsigned old = xb_add(&bar[XB_XSUB(b.x)], 1u);
        const unsigned gen = old / nloc;
        if (old + 1u == (gen + 1u) * nloc) {
            __builtin_amdgcn_fence(__ATOMIC_RELEASE, "agent");
            asm volatile("s_waitcnt vmcnt(0)" ::: "memory");
            const unsigned og = xb_add(&bar[XB_TOP], 1u);
            const unsigned tg = og / nx;
            if (og + 1u == (tg + 1u) * nx) xb_add(&bar[XB_TOPGEN], 1u);
            else XB_SPIN(xb_ld(&bar[XB_TOPGEN]) == tg, bar);
            __builtin_amdgcn_fence(__ATOMIC_ACQUIRE, "agent");
            xb_add(&bar[XB_XGEN(b.x)], 1u);
            asm volatile("s_waitcnt vmcnt(0)" ::: "memory");
        } else {
            XB_SPIN(xb_ld(&bar[XB_XGEN(b.x)]) == gen, bar);
            __builtin_amdgcn_fence(__ATOMIC_ACQUIRE, "agent");
            asm volatile("s_waitcnt vmcnt(0)" ::: "memory");
        }
    }
    __syncthreads();
}

__global__ void __launch_bounds__(NTHR) fwd_megakernel(Args a_unused) {
    extern __shared__ __attribute__((aligned(16))) unsigned char lds_raw[];
    cg::grid_group grid = cg::this_grid();
    const int ph_lo = a_unused.ph_lo, ph_hi = a_unused.ph_hi;
    const int wave0 = __builtin_amdgcn_readfirstlane((int)(threadIdx.x >> 6));
    XcdBarrier xbar;
    { volatile LAS unsigned* st = (volatile LAS unsigned*)((LAS unsigned char*)lds_raw + LDS_BYTES - 64);
      if (threadIdx.x < 2) st[threadIdx.x] = 0u;
      __syncthreads();
      xbar = xcd_barrier_post((unsigned*)(a_unused.ws + OFF_BAR), st, (int)threadIdx.x); }
    int rep = 0; (void)rep;
    for (int ph = ph_lo; ph < ph_hi; ++ph) {
        ArgP a = (ArgP)__builtin_amdgcn_kernarg_segment_ptr();
        asm volatile("" : "+s"(a));
        LAS unsigned char* lds = (LAS unsigned char*)lds_raw;
        int bid = blockIdx.x, G = gridDim.x, wave = wave0;
        asm volatile("" : "+s"(bid)); asm volatile("" : "+s"(G)); asm volatile("" : "+s"(wave));
        const int gw = bid * NWAVES + wave, NGW = G * NWAVES;
#define GETLANE() int lane; asm volatile("v_mbcnt_lo_u32_b32 %0, -1, 0\n\tv_mbcnt_hi_u32_b32 %0, -1, %0" : "=v"(lane)); const int tid = wave * 64 + lane
#if defined(PROBE_PARTS)
        const int pm = rep ? PROBE_PARTS : 7;
#else
        const int pm = 7;
#endif
        unsigned char* ws = a->ws;
        float* hl = a->out; float* hc = (float*)(ws + OFF_HC);
        bf16_t* XN = (bf16_t*)(ws + OFF_XN);
        unsigned char* wb = ws + OFF_W;
        if (ph == 0) { GETLANE(); p0_phase(a, lds, tid, wave, lane, bid, G); }
        else {
            const int l = (ph - 1) / 13, j = (ph - 1) % 13;
            const float* modl = (const float*)(ws + OFF_MOD) + (size_t)l * 5 * 9216;
            const int nctx = (l == DEPTH - 1 && j >= 9) ? 0 : 4;
            if (j == 0) { GETLANE(); (void)tid; convert_weights(a, l, lds, gw, NGW, wave, lane); norm_phase(hl, hc, a->in[6] + l * D, modl, 0, XN, gw, NGW, lane, MTOT, (const float*)(ws + OFF_PART), l > 0 ? 11 : 0); }
            else if (j == 3) { GETLANE(); (void)tid; norm_phase(hl, hc, a->in[9] + l * D, modl, 3, XN, gw, NGW, lane, MTOT, (const float*)(ws + OFF_PART), 11); }
            else if (j == 10) { GETLANE(); (void)tid; norm_phase(hl, hc, a->in[28] + l * D, modl, 6, XN, gw, NGW, lane, nctx ? MTOT : MLAT, (const float*)(ws + OFF_PART), nctx ? 4 : 0); }
            else if (j == 1 || j == 11) {
                GETLANE(); (void)lane;
                pg8::Gemm g{XN, (const bf16_t*)(wb + (j == 1 ? W_FFN1_IN : W_FFN2_IN)), MTOT, 2 * DFF, D}; CtxOrder S; S.init(2 * DFF, D, G, bid, nctx, 1);
                EpiSwiGLU E{(bf16_t*)(ws + OFF_HFF)}; pg8::gemm_phase<EpiSwiGLU, CtxOrder, true, true>(lds, g, S, E, tid); }
            else if (j == 2 || j == 9 || j == 12) {
                GETLANE(); (void)lane;
                const bf16_t* A = j == 9 ? XN : (const bf16_t*)(ws + OFF_HFF);
                const bf16_t* Bt = (const bf16_t*)(wb + (j == 2 ? W_FFN1_OUT : (j == 9 ? W_OUT : W_FFN2_OUT)));
                const int Kd = j == 9 ? D : DFF;
                pg8::Gemm g{A, Bt, MTOT, D, Kd}; CtxOrder S; S.init(D, Kd, G, bid, nctx, j == 9 ? 4 : 11);
                EpiResid E{hl, hc, modl + (j == 2 ? 2 : (j == 9 ? 5 : 8)) * 1024, j == 9 ? 1.0f : 0.5f}; pg8::gemm_phase<EpiResid, CtxOrder, true, true>(lds, g, S, E, tid); }
            else if (j == 4 || j == 6) {
                const int ng = j == 4 ? 1 : 2;
                for (int q = 0; q < ng; ++q) {
                    GETLANE(); (void)lane;
                    const bf16_t* A; const bf16_t* Bt; bf16_t* O; int N, K, ldc;
                    if (j == 4) { A = XN; Bt = (const bf16_t*)(wb + W_IN); O = (bf16_t*)(ws + OFF_Z); N = 2048; K = D; ldc = INW; }
                    else if (q == 0) { A = (const bf16_t*)(ws + OFF_CQN); Bt = (const bf16_t*)(wb + W_UQ); O = (bf16_t*)(ws + OFF_QRAW); N = 768; K = 256; ldc = 576; }
                    else { A = (const bf16_t*)(ws + OFF_CKVN); Bt = (const bf16_t*)(wb + W_UKV); O = (bf16_t*)(ws + OFF_KVRAW); N = 768; K = 256; ldc = 768; }
                    pg8::Gemm g{A, Bt, MTOT, N, K}; CtxOrder S; S.init(N, K, G, bid, 4, 1);
                    EpiStore E{O, ldc, ldc}; pg8::gemm_phase<EpiStore, CtxOrder, true, true>(lds, g, S, E, tid);
                } }
            else if (j == 5) { GETLANE(); if (pm & 1) mixprep_rows(a, l, gw, NGW, lane);
                if (pm & 4) for (int tl = bid; tl < 528; tl += G) mixprep_tile(a, l, tl, lds, tid, wave, lane, pm);
                if (pm & 2) lru_wave_phase<false>(a, l, lds, gw, NGW, wave, lane, tid); }
            else if (j == 7) {
                GETLANE();
                if (pm & 1) mlapost_rows(a, l, gw, NGW, lane);
                if (pm & 2) for (int tl = bid; tl < 528; tl += G) mlapost_tile(a, l, tl, lds, tid, wave, lane, pm);
                if ((pm & 4) && wave == 0) { for (int item = G - 1 - bid; item < 48; item += G) lru_carry(a, item, lane); } }
            else if (j == 8) {
                bf16_t* Y = XN;
                const int vb = (G & 7) == 0 ? (bid & 7) * (G >> 3) + (bid >> 3) : bid;
                if (pm & 1) { GETLANE(); (void)lane;
                    for (int u = vb; u < 256; u += G) {
                        int bh, idx; if (u < 176) { bh = u / 11; idx = u % 11; } else { const int v = u - 176; bh = 16 + v / 10; idx = v % 10; }
                        const int b = bh / 6, hh = bh % 6;
                        bf16_t* Yb = Y + (size_t)(b * T + 512 * idx) * D + 384 + hh * 64;
                        attn_unit_mla64(lds, (const bf16_t*)(ws + OFF_QM) + (size_t)bh * P * 96, (const bf16_t*)(ws + OFF_KM) + (size_t)bh * P * 96, (const bf16_t*)(ws + OFF_VMT) + (size_t)bh * 64 * P, Yb, idx, tid); }
                    for (int u = vb; u < 256; u += G) {
                        int bh, qs; if (u < 160) { bh = u / 10; qs = 5632 + 256 * (u % 10); } else { const int v = u - 160; bh = 16 + v / 12; qs = 5120 + 256 * (v % 12); }
                        const int b = bh / 6, hh = bh % 6;
                        bf16_t* Yb = Y + (size_t)(b * T + qs) * D + 384 + hh * 64;
                        attn_unit<96, false>(lds, (const bf16_t*)(ws + OFF_QM) + (size_t)bh * P * 96, (const bf16_t*)(ws + OFF_KM) + (size_t)bh * P * 96, (const bf16_t*)(ws + OFF_VMT) + (size_t)bh * 64 * P, Yb, 1 + qs / 256, nullptr, tid); }
                    if (l != DEPTH - 1) for (int u = vb; u < 24; u += G) {
                        const int b = u / 6, hh = u % 6; const size_t bh = (size_t)(b * 6 + hh);
                        bf16_t* Yb = Y + (size_t)(MLAT + b * C) * D + 384 + hh * 64;
                        attn_unit<96, false>(lds, (const bf16_t*)(ws + OFF_QM) + bh * P * 96, (const bf16_t*)(ws + OFF_KM) + bh * P * 96, (const bf16_t*)(ws + OFF_VMT) + bh * 64 * P, Yb, 0, nullptr, tid); }
                }
                { GETLANE(); (void)lane;
                LAS float* rpbl = (LAS float*)(lds + 49152);
                for (int i = tid; i < 4 * 465; i += NTHR) rpbl[i] = a->in[27][l * 4 * 465 + i] * LOG2E;
                __syncthreads();
                const int na_n = (G == 256 && l != DEPTH - 1 && vb >= G - 16) ? 3 : 2;
                if (pm & 2) for (int i = 0; (G == 256) ? (i < na_n && (i < 2 ? vb + i * G < 512 : true)) : (vb + i * G < (l == DEPTH - 1 ? 512 : 528)); ++i) {
                    const int u = (G == 256 && i == 2) ? 512 + (G - 1 - vb) : vb + i * G;
                    int b, hh, qb; if (u < 512) { b = u / 128; hh = (u % 128) / 32; qb = 1 + (u & 31); } else { const int v = u - 512; b = v / 4; hh = v % 4; qb = 0; }
                    const size_t bh = (size_t)(b * 4 + hh);
                    bf16_t* Yb = Y + (size_t)(qb == 0 ? MLAT + b * C : b * T + 256 * (qb - 1)) * D + 768 + hh * 64;
                    attn_unit<64, true>(lds, (const bf16_t*)(ws + OFF_NQ) + bh * P * 64, (const bf16_t*)(ws + OFF_NK) + bh * P * 64, (const bf16_t*)(ws + OFF_NVT) + bh * 64 * P, Yb, qb, rpbl + hh * 465, tid);
                } }
                if (pm & 4) { GETLANE(); lru_wave_phase<true>(a, l, lds, gw, NGW, wave, lane, tid, l == DEPTH - 1 ? 1024 : 1056); }
            }
        }
#if defined(PROBE_SYNC2)
        if (ph + 1 < ph_hi) { GETLANE(); xcd_barrier(xbar, tid); }
#endif
#if defined(PROBE_REPEAT)
        if (ph > 0 && ((ph - 1) % 13) == PROBE_REPEAT && !rep) { rep = 1; --ph; } else rep = 0;
#endif
        if (ph + 1 < ph_hi) { if (ph == 0) grid.sync(); else { int l2; asm volatile("v_mbcnt_lo_u32_b32 %0, -1, 0\n\tv_mbcnt_hi_u32_b32 %0, -1, %0" : "=v"(l2)); xcd_barrier(xbar, wave0 * 64 + l2); } }
    }
}

extern "C" void kernel_launch(void* const* d_in, const int* in_sizes, int n_in, void* d_out, int out_size, void* d_ws, size_t ws_size, hipStream_t stream) {
    static int grid = 0;
    if (grid == 0) {
        if (n_in != 31 || out_size != MLAT * D || ws_size < WS_END2) { fprintf(stderr, "kernel_launch: unexpected problem (n_in %d, out %d, ws %zu < %zu)\n", n_in, out_size, ws_size, (size_t)WS_END2); grid = -1; return; }
        int dev = 0, cus = 0, per_cu = 0;
        hipGetDevice(&dev); hipDeviceGetAttribute(&cus, hipDeviceAttributeMultiprocessorCount, dev);
        if (hipFuncSetAttribute((const void*)fwd_megakernel, hipFuncAttributeMaxDynamicSharedMemorySize, LDS_BYTES) != hipSuccess) { fprintf(stderr, "kernel_launch: hipFuncSetAttribute failed\n"); grid = -1; return; }
        if (hipOccupancyMaxActiveBlocksPerMultiprocessor(&per_cu, (const void*)fwd_megakernel, NTHR, LDS_BYTES) != hipSuccess || per_cu < 1) { fprintf(stderr, "kernel_launch: occupancy query says %d\n", per_cu); per_cu = 1; }
        (void)hipGetLastError();
        grid = cus;
    }
    if (grid < 0) return;
    if (hipMemsetAsync((char*)d_ws + OFF_BAR, 0, XCD_BAR_WORDS * 4, stream) != hipSuccess) { fprintf(stderr, "kernel_launch: memset of the barrier words failed\n"); return; }
    Args a{};
    for (int i = 0; i < 31; ++i) a.in[i] = (const float*)d_in[i];
    a.out = (float*)d_out; a.ws = (unsigned char*)d_ws; a.ph_lo = 0; a.ph_hi = 1 + 13 * DEPTH;
    void* args[] = {&a};
    hipError_t e = hipLaunchCooperativeKernel((const void*)fwd_megakernel, dim3(grid), dim3(NTHR), args, LDS_BYTES, stream);
    if (e != hipSuccess) fprintf(stderr, "kernel_launch: cooperative launch failed: %s (grid %d)\n", hipGetErrorString(e), grid);
}
```
